# Optimizing an MI355X kernel written in HIP

```python
import jax, jax.numpy as jnp
from jax import lax
import numpy as np

D_MODEL = 2048
BATCH = 4
SEQ = 4096
DEPTH = 2

N_META = 16
MIX_WIDTH = 1024
N_BRANCH = 3
MLSTM_HEADS = 8
MLSTM_HEAD_DIM = MIX_WIDTH // MLSTM_HEADS
MLSTM_CHUNK = 64
CONV_WIDTH = 3
POOL_WINDOWS = (2, 4, 8, 16)
POOL_GROUP = MIX_WIDTH // len(POOL_WINDOWS)
D_FF = 5632
RMS_EPS = 1e-6
MIXER_SPLITS = (MIX_WIDTH, MIX_WIDTH, MIX_WIDTH, MIX_WIDTH, MLSTM_HEADS, MLSTM_HEADS,
                MIX_WIDTH, MIX_WIDTH, MIX_WIDTH, MIX_WIDTH, N_BRANCH * D_MODEL)
IN_COLS = 8 * MIX_WIDTH + 2 * MLSTM_HEADS + N_BRANCH * D_MODEL

kernel_name = "hybrid_mlstm_shortconv_pool_gated_block"


def rms_norm(x, g):
    xf = x.astype(jnp.float32)
    y = xf * lax.rsqrt(jnp.mean(xf * xf, axis=-1, keepdims=True) + RMS_EPS)
    return (y * g.astype(jnp.float32)).astype(x.dtype)


def causal_dwconv(u, w):
    K = w.shape[0]
    L = u.shape[1]
    up = jnp.pad(u, ((0, 0), (K - 1, 0), (0, 0)))
    y = up[:, 0:L] * w[0]
    for j in range(1, K):
        y = y + up[:, j:j + L] * w[j]
    return y


def mlstm_chunk(state, q, k, v, logi, logf):
    C, n, m = state
    T = q.shape[2]
    b = jnp.cumsum(logf, axis=-1)
    D = b[..., :, None] - b[..., None, :] + logi[..., None, :]
    causal = jnp.tril(jnp.ones((T, T), dtype=bool))
    D = jnp.where(causal, D, -jnp.inf)
    inter = b + m[..., None]
    m_t = jnp.maximum(inter, jnp.max(D, axis=-1))
    inter_w = jnp.exp(inter - m_t)
    s = jnp.einsum('bhtd,bhsd->bhts', q, k) * jnp.exp(D - m_t[..., None])
    num = inter_w[..., None] * jnp.einsum('bhtd,bhde->bhte', q, C) + jnp.einsum('bhts,bhse->bhte', s, v)
    den = inter_w * jnp.einsum('bhtd,bhd->bht', q, n) + jnp.sum(s, axis=-1)
    h = num / jnp.maximum(jnp.abs(den), jnp.exp(-m_t))[..., None]
    b_T = b[..., -1]
    w_log = b_T[..., None] - b + logi
    m_new = jnp.maximum(b_T + m, jnp.max(w_log, axis=-1))
    decay = jnp.exp(b_T + m - m_new)
    ws = jnp.exp(w_log - m_new[..., None])
    C_new = decay[..., None, None] * C + jnp.einsum('bhs,bhsd,bhse->bhde', ws, k, v)
    n_new = decay[..., None] * n + jnp.einsum('bhs,bhsd->bhd', ws, k)
    return (C_new, n_new, m_new), h


def mlstm(q, k, v, i_pre, f_pre, o_pre, head_gain):
    B, L, _ = q.shape
    H, Dh, CH = MLSTM_HEADS, MLSTM_HEAD_DIM, MLSTM_CHUNK
    n_chunks = (L - N_META) // CH

    def heads(t):
        return t.astype(jnp.float32).reshape(B, L, H, Dh).transpose(0, 2, 1, 3)

    qh = heads(q) * (Dh ** -0.5)
    kh = heads(k)
    vh = heads(v)
    logi = i_pre.astype(jnp.float32).transpose(0, 2, 1)
    logf = jax.nn.log_sigmoid(f_pre.astype(jnp.float32)).transpose(0, 2, 1)

    def meta(t):
        return t[:, :, :N_META]

    def chunks(t):
        t = t[:, :, N_META:]
        t = t.reshape((B, H, n_chunks, CH) + t.shape[3:])
        return jnp.moveaxis(t, 2, 0)

    init = (jnp.zeros((B, H, Dh, Dh), jnp.float32), jnp.zeros((B, H, Dh), jnp.float32),
            jnp.zeros((B, H), jnp.float32))
    state, h_meta = mlstm_chunk(init, meta(qh), meta(kh), meta(vh), meta(logi), meta(logf))
    xs = (chunks(qh), chunks(kh), chunks(vh), chunks(logi), chunks(logf))
    _, h_real = lax.scan(lambda st, c: mlstm_chunk(st, *c), state, xs)
    h_real = jnp.moveaxis(h_real, 0, 2).reshape(B, H, n_chunks * CH, Dh)
    h = jnp.concatenate([h_meta, h_real], axis=2)
    h = h * lax.rsqrt(jnp.mean(h * h, axis=-1, keepdims=True) + RMS_EPS)
    h = h.transpose(0, 2, 1, 3).reshape(B, L, H * Dh) * head_gain.astype(jnp.float32)
    return (h * jax.nn.sigmoid(o_pre.astype(jnp.float32))).astype(q.dtype)


def multiscale_pool(u, pool_w, pool_scale):
    B, L, _ = u.shape
    uf = u.astype(jnp.float32)
    cs = jnp.pad(jnp.cumsum(uf, axis=1), ((0, 0), (1, 0), (0, 0)))
    t = jnp.arange(L)
    outs = []
    for g, w in enumerate(POOL_WINDOWS):
        csg = cs[..., g * POOL_GROUP:(g + 1) * POOL_GROUP]
        lagged = jnp.pad(csg, ((0, 0), (w - 1, 0), (0, 0)))[:, :L]
        count = jnp.minimum(t + 1, w).astype(jnp.float32)[None, :, None]
        outs.append((csg[:, 1:] - lagged) / count - uf[..., g * POOL_GROUP:(g + 1) * POOL_GROUP])
    p = jnp.stack(outs, axis=2)
    y = jnp.einsum('blgc,gcd->blgd', p, pool_w.astype(jnp.float32)).reshape(B, L, MIX_WIDTH)
    return (y * pool_scale.astype(jnp.float32)).astype(u.dtype)


def token_mixer(h, w_in, b_if, head_gain, conv_w, pool_w, pool_scale, w_branch, w_out):
    B, L, _ = h.shape
    offsets = [int(o) for o in np.cumsum(MIXER_SPLITS)[:-1]]
    q, k, v, o, ip, fp, cb, cc, cx, pu, gates = jnp.split(h @ w_in, offsets, axis=-1)
    y_a = mlstm(q, k, v, ip + b_if[0], fp + b_if[1], o, head_gain)
    y_b = cb * causal_dwconv(cc * cx, conv_w)
    y_c = multiscale_pool(pu, pool_w, pool_scale)
    ys = jnp.stack([y_a, y_b, y_c], axis=2)
    branch = jnp.einsum('blnc,ncd->blnd', ys, w_branch)
    g = jax.nn.sigmoid(gates.reshape(B, L, N_BRANCH, D_MODEL))
    merged = jnp.sum(g * branch, axis=2)
    return merged @ w_out


def conv_ffn(h, w_ffn_in, conv_w, w_ffn_out):
    a, u = jnp.split(h @ w_ffn_in, 2, axis=-1)
    a = causal_dwconv(a, conv_w)
    return (jax.nn.gelu(a, approximate=True) * u) @ w_ffn_out


def setup_inputs(seed: int = 0) -> dict:
    key = jax.random.key(seed)
    ks = jax.random.split(key, 20)
    nrm = jax.random.normal
    f_bias = jnp.linspace(3.0, 6.0, MLSTM_HEADS)[None, :] + 0.1 * nrm(ks[8], (DEPTH, MLSTM_HEADS))
    i_bias = 0.1 * nrm(ks[7], (DEPTH, MLSTM_HEADS))
    return {
        "x": nrm(ks[0], (BATCH, SEQ, D_MODEL)),
        "meta_tokens": nrm(ks[1], (N_META, D_MODEL)),
        "norm_pre_mix": 1.0 + 0.05 * nrm(ks[2], (DEPTH, D_MODEL)),
        "norm_post_mix": 1.0 + 0.05 * nrm(ks[3], (DEPTH, D_MODEL)),
        "norm_pre_ffn": 1.0 + 0.05 * nrm(ks[4], (DEPTH, D_MODEL)),
        "norm_post_ffn": 1.0 + 0.05 * nrm(ks[5], (DEPTH, D_MODEL)),
        "w_in": nrm(ks[6], (DEPTH, D_MODEL, IN_COLS)) * D_MODEL ** -0.5,
        "b_if": jnp.stack([i_bias, f_bias], axis=1),
        "mlstm_head_gain": 1.0 + 0.05 * nrm(ks[9], (DEPTH, MIX_WIDTH)),
        "conv_mix_w": nrm(ks[10], (DEPTH, CONV_WIDTH, MIX_WIDTH)) * CONV_WIDTH ** -0.5,
        "pool_w": nrm(ks[11], (DEPTH, len(POOL_WINDOWS), POOL_GROUP, POOL_GROUP)) * POOL_GROUP ** -0.5,
        "pool_scale": 1.0 + 0.1 * nrm(ks[12], (DEPTH, MIX_WIDTH)),
        "w_branch": nrm(ks[13], (DEPTH, N_BRANCH, MIX_WIDTH, D_MODEL)) * MIX_WIDTH ** -0.5,
        "w_out": nrm(ks[14], (DEPTH, D_MODEL, D_MODEL)) * D_MODEL ** -0.5,
        "w_ffn_in": nrm(ks[15], (DEPTH, D_MODEL, 2 * D_FF)) * D_MODEL ** -0.5,
        "ffn_conv_w": nrm(ks[16], (DEPTH, CONV_WIDTH, D_FF)) * CONV_WIDTH ** -0.5,
        "w_ffn_out": nrm(ks[17], (DEPTH, D_FF, D_MODEL)) * D_FF ** -0.5,
    }


def reference(x, meta_tokens, norm_pre_mix, norm_post_mix, norm_pre_ffn, norm_post_ffn, w_in, b_if,
              mlstm_head_gain, conv_mix_w, pool_w, pool_scale, w_branch, w_out, w_ffn_in, ffn_conv_w,
              w_ffn_out):
    B = x.shape[0]
    meta = jnp.broadcast_to(meta_tokens.astype(x.dtype)[None], (B, N_META, D_MODEL))
    x = jnp.concatenate([meta, x], axis=1)
    for l in range(DEPTH):
        h = rms_norm(x, norm_pre_mix[l])
        mix = token_mixer(h, w_in[l], b_if[l], mlstm_head_gain[l], conv_mix_w[l], pool_w[l],
                          pool_scale[l], w_branch[l], w_out[l])
        x = x + rms_norm(mix, norm_post_mix[l])
        h = rms_norm(x, norm_pre_ffn[l])
        x = x + rms_norm(conv_ffn(h, w_ffn_in[l], ffn_conv_w[l], w_ffn_out[l]), norm_post_ffn[l])
    return x[:, N_META:]
```

```cpp
#include <hip/hip_runtime.h>
#include <cstdio>
#include <cstdint>

#define LAS __attribute__((address_space(3)))
#define GAS __attribute__((address_space(1)))
typedef unsigned short bf16;
typedef short bf16x8 __attribute__((ext_vector_type(8)));
typedef float f32x4 __attribute__((ext_vector_type(4)));
typedef float f32x2 __attribute__((ext_vector_type(2)));
typedef unsigned u32x4 __attribute__((ext_vector_type(4)));
typedef unsigned u32x2 __attribute__((ext_vector_type(2)));
typedef GAS unsigned gu32;

constexpr int DM = 2048, NB = 4, SEQ = 4096, NMETA = 16, MIXW = 1024, NHEAD = 8, DHEAD = 128, DFF = 5632, DEPTH = 2;
constexpr int MR = NB * SEQ;
constexpr int MT = MR + NMETA;
constexpr int NIN = 14336;
constexpr int INCOLS = 14352;
constexpr int ZP = 8256;
constexpr int NIN_ROWS = 14400;
constexpr float RMS_EPS = 1e-6f;
constexpr int ZQ = 0, ZK = 1024, ZV = 2048, ZO = 3072, ZCB = 4096, ZCC = 5120, ZCX = 6144, ZPU = 7168, ZG = 8192;

constexpr size_t MiB = 1u << 20;
constexpr size_t WS_CTL = 0, CTL_ZERO_BYTES = 64 * 1024;
constexpr size_t WS_IF = 1 * MiB;
constexpr size_t WS_XM = 3 * MiB;
constexpr size_t WS_GM = 3 * MiB + 256 * 1024;
constexpr size_t WS_W = 4 * MiB;
constexpr size_t W_IN = 0, W_BR = W_IN + (size_t)NIN_ROWS * DM * 2, W_OUT = W_BR + (size_t)DM * 3072 * 2, W_FFI = W_OUT + (size_t)DM * DM * 2,
                 W_FFO = W_FFI + (size_t)2 * DFF * DM * 2, W_END = W_FFO + (size_t)DM * DFF * 2;
static_assert(W_END <= 143 * MiB, "weights");
constexpr size_t WS_Z = 147 * MiB;
constexpr size_t WS_GT = 406 * MiB;
constexpr size_t WS_ACT = WS_Z;
constexpr size_t WS_EA = WS_Z + 180 * MiB;
constexpr size_t WS_EU = WS_Z + 188 * MiB;
constexpr size_t WS_AUM = WS_Z + 192 * MiB;
constexpr size_t WS_YS = 598 * MiB;
constexpr size_t WS_H = WS_YS;
constexpr size_t WS_H8 = WS_YS + (size_t)MT * DM * 2;

constexpr size_t WS_MG = 695 * MiB;
constexpr size_t WS_XB = WS_MG;
constexpr size_t WS_MIX = 760 * MiB;
constexpr size_t WS_END = 840 * MiB;
static_assert(WS_H + (size_t)MT * DM * 2 <= WS_H8 && WS_H8 + (size_t)MT * DM <= WS_MG, "H8");
static_assert(WS_Z + (size_t)MT * ZP * 2 <= WS_GT && WS_GT + (size_t)64 * 24 * 65536 <= WS_YS && WS_ACT + (size_t)MT * DFF * 2 <= WS_EA && WS_EA + (size_t)64 * 4 * DFF * 4 <= WS_EU && WS_EU + (size_t)64 * 2 * DFF * 4 <= WS_AUM && WS_AUM + (size_t)16 * 2 * DFF * 4 <= WS_YS, "map1");
static_assert(WS_YS + (size_t)MT * 3072 * 2 <= WS_MG && WS_MG + (size_t)MT * DM * 2 <= WS_MIX && WS_MIX + (size_t)80 * MiB <= WS_END && (size_t)MT * DM * 2 <= 80 * MiB, "map2");
constexpr int CW_BAR = 4096;

__device__ __forceinline__ unsigned f2bf(float f) { unsigned u = __builtin_bit_cast(unsigned, f); return (u + 0x7fffu + ((u >> 16) & 1u)) >> 16; }
__device__ __forceinline__ unsigned pk2(float lo, float hi) { return f2bf(lo) | (f2bf(hi) << 16); }
__device__ __forceinline__ float bf2f(bf16 b) { return __builtin_bit_cast(float, (unsigned)b << 16); }
__device__ __forceinline__ float bflo(unsigned w) { return __builtin_bit_cast(float, w << 16); }
__device__ __forceinline__ float bfhi(unsigned w) { return __builtin_bit_cast(float, w & 0xffff0000u); }
__device__ __forceinline__ float sigmoidf_(float x) { return __builtin_amdgcn_rcpf(1.0f + __builtin_amdgcn_exp2f(-1.4426950408889634f * x)); }
__device__ __forceinline__ float wave_sum(float v) {
#pragma unroll
    for (int o = 1; o < 64; o <<= 1) v += __shfl_xor(v, o);
    return v;
}
__device__ __forceinline__ float gelu_tanh(float x) {
    const float p = x * __builtin_fmaf(0.1029432396f * x, x, 2.3022081981f);
    return x * __builtin_amdgcn_rcpf(1.0f + __builtin_amdgcn_exp2f(-p));
}
__device__ __forceinline__ int prow(int b, int pos) { return pos < NMETA ? MR + pos : b * SEQ + pos - NMETA; }
__device__ __forceinline__ int lane_id() { int l; asm volatile("v_mbcnt_lo_u32_b32 %0, -1, 0\n\tv_mbcnt_hi_u32_b32 %0, -1, %0" : "=v"(l)); return l; }
#define LDS_WAIT() asm volatile("s_waitcnt lgkmcnt(0)" ::: "memory")
#define VM_WAIT() asm volatile("s_waitcnt vmcnt(0)" ::: "memory")

namespace pg8 {
constexpr int BM = 256, BK = 64, HALF = 128, HTB = HALF * BK * 2, STAGE_BYTES = 8 * HTB, NXCD = 8, WGM = 8;
__host__ __device__ __forceinline__ int lds_byte(int r, int c) { const int st = (r >> 4) * 2 + (c >> 5), rr = r & 15, cc = c & 31, ob = rr * 64 + cc * 2; return st * 1024 + (ob ^ (((ob >> 9) & 1) << 5)); }
__host__ __device__ __forceinline__ void stage_rc(int b, int& R, int& C) { const int st = b / 1024, sb = b % 1024, swz = sb ^ (((sb >> 9) & 1) << 5); R = (st >> 1) * 16 + swz / 64; C = (st & 1) * 32 + (swz % 64) / 2; }
__host__ __device__ __forceinline__ int perm32(int rho) { const int n = rho >> 4, i = rho & 15; return 8 * (i >> 2) + 4 * n + (i & 3); }

typedef int v8i32 __attribute__((ext_vector_type(8)));
typedef int v4i32 __attribute__((ext_vector_type(4)));
__device__ __forceinline__ v8i32 cat8(const bf16x8 a, const bf16x8 b) { const v4i32 x = __builtin_bit_cast(v4i32, a), y = __builtin_bit_cast(v4i32, b); return __builtin_shufflevector(x, y, 0, 1, 2, 3, 4, 5, 6, 7); }
struct Unit { int pm, pn; };
struct Gemm { const bf16* A; const bf16* Bt; int lda, ldb, K; };

__device__ __forceinline__ void tile_of(int wgid, int nM, int nN, int& pm, int& pn) {
    const int nwg = nM * nN;
    { const int q = nwg / NXCD, r = nwg % NXCD, xcd = wgid % NXCD, off = wgid / NXCD; wgid = (xcd < r ? xcd * (q + 1) : r * (q + 1) + (xcd - r) * q) + off; }
    const int nig = WGM * nN, gid = wgid / nig, fm = gid * WGM, gsz = (nM - fm) < WGM ? (nM - fm) : WGM;
    pm = fm + ((wgid % nig) % gsz); pn = (wgid % nig) / gsz;
}
struct OrderStd {
    int nM, nN, nwg, G, c;
    __device__ void init(int M, int N, int G_, int c_) { nM = M / BM; nN = N / BM; nwg = nM * nN; G = G_; c = c_; }
    __device__ bool next(int i, Unit& u) const {
        const long L = (long)i * G + c; if (L >= nwg) return false;
        tile_of((int)L, nM, nN, u.pm, u.pn); return true;
    }
};
__device__ __forceinline__ unsigned cvt_pk_bf16(float lo, float hi) { unsigned r; asm volatile("v_cvt_pk_bf16_f32 %0, %1, %2" : "=v"(r) : "v"(lo), "v"(hi)); return r; }

struct EpiF32 {
    static constexpr bool PERM = false, HAS_MID = false, PIPE = false;
    float* C; int ldc;
    __device__ __forceinline__ void operator()(const f32x4 (&acc)[2][2][4][2], const Unit& u, int wr, int wc, int fr, int fq) const {
        const int row0 = u.pm * BM + wr * 64 + fr, col0 = u.pn * BM + wc * 32 + 4 * fq;
#pragma unroll
        for (int ai = 0; ai < 2; ++ai)
#pragma unroll
            for (int m = 0; m < 4; ++m) { float* rowp = C + (size_t)(row0 + ai * HALF + m * 16) * ldc + col0;
#pragma unroll
                for (int bj = 0; bj < 2; ++bj)
#pragma unroll
                    for (int n = 0; n < 2; ++n) *(f32x4*)(rowp + bj * HALF + n * 16) = acc[ai][bj][m][n]; }
    }
};
struct EpiBf16 {
    static constexpr bool PERM = true, HAS_MID = false, PIPE = true;
    bf16* O; int ldc;
    __device__ __forceinline__ void slice(const f32x4 (&acc)[2][2][4][2], const Unit& u, int ai, int m, int wr, int wc, int fr, int fq) const {
        bf16* rowp = O + (size_t)(u.pm * BM + wr * 64 + fr + ai * HALF + m * 16) * ldc + (u.pn * BM + wc * 32 + 8 * fq);
#pragma unroll
        for (int bj = 0; bj < 2; ++bj) { const f32x4 v0 = acc[ai][bj][m][0], v1 = acc[ai][bj][m][1];
            u32x4 w; w.x = cvt_pk_bf16(v0[0], v0[1]); w.y = cvt_pk_bf16(v0[2], v0[3]); w.z = cvt_pk_bf16(v1[0], v1[1]); w.w = cvt_pk_bf16(v1[2], v1[3]);
            *(u32x4*)(rowp + bj * HALF) = w; }
    }
    __device__ __forceinline__ void operator()(const f32x4 (&acc)[2][2][4][2], const Unit& u, int wr, int wc, int fr, int fq) const {
#pragma unroll
        for (int ai = 0; ai < 2; ++ai)
#pragma unroll
            for (int m = 0; m < 4; ++m) slice(acc, u, ai, m, wr, wc, fr, fq);
    }
};
constexpr int GT_COLS = 24;
__device__ __forceinline__ float ub0(unsigned x) { return (float)(x & 0xffu); }
__device__ __forceinline__ float ub1(unsigned x) { return (float)((x >> 8) & 0xffu); }
__device__ __forceinline__ float ub2(unsigned x) { return (float)((x >> 16) & 0xffu); }
__device__ __forceinline__ float ub3(unsigned x) { return (float)(x >> 24); }
struct EpiGate {
    static constexpr bool PERM = true, HAS_MID = false, PIPE = false;
    unsigned char* G; float gscale;
    static __device__ __forceinline__ unsigned q4(const f32x4 v, float gs) { unsigned p = 0;
        p = __builtin_amdgcn_cvt_pk_u8_f32(__builtin_rintf(255.0f * sigmoidf_(v[0] * gs)), 0, p); p = __builtin_amdgcn_cvt_pk_u8_f32(__builtin_rintf(255.0f * sigmoidf_(v[1] * gs)), 1, p);
        p = __builtin_amdgcn_cvt_pk_u8_f32(__builtin_rintf(255.0f * sigmoidf_(v[2] * gs)), 2, p); p = __builtin_amdgcn_cvt_pk_u8_f32(__builtin_rintf(255.0f * sigmoidf_(v[3] * gs)), 3, p); return p; }
    __device__ __forceinline__ void operator()(const f32x4 (&acc)[2][2][4][2], const Unit& u, int wr, int wc, int fr, int fq) const {
        unsigned char* base = G + ((size_t)(u.pm * GT_COLS + u.pn) << 16) + ((((wr * 4 + wc) * 64) + fq * 16 + fr) << 4);
#pragma unroll
        for (int ai = 0; ai < 2; ++ai)
#pragma unroll
            for (int m = 0; m < 4; ++m) { u32x4 w;
                w.x = q4(acc[ai][0][m][0], gscale); w.y = q4(acc[ai][0][m][1], gscale); w.z = q4(acc[ai][1][m][0], gscale); w.w = q4(acc[ai][1][m][1], gscale);
                *(u32x4*)(base + ((ai * 4 + m) << 13)) = w; }
    }
};
struct EpiBranch {
    static constexpr bool PERM = true, HAS_MID = true, PIPE = false;
    const unsigned char* Gt;
    bf16* MG;
    static __device__ __forceinline__ float fl(float g) { return fmaxf(g, 1e-30f); }
    static __device__ __forceinline__ void rs4(f32x4& v, unsigned a, unsigned b) {
        v[0] *= fl(ub0(a)) * __builtin_amdgcn_rcpf(fl(ub0(b))); v[1] *= fl(ub1(a)) * __builtin_amdgcn_rcpf(fl(ub1(b)));
        v[2] *= fl(ub2(a)) * __builtin_amdgcn_rcpf(fl(ub2(b))); v[3] *= fl(ub3(a)) * __builtin_amdgcn_rcpf(fl(ub3(b))); }
    __device__ __forceinline__ void mid(f32x4 (&acc)[2][2][4][2], const Unit& u, int sidx, int wr, int wc, int fr, int fq) const {
        asm volatile("" : "+v"(fr), "+v"(fq));
        const unsigned char* gp = Gt + ((size_t)(u.pm * GT_COLS + (sidx - 1) * 8 + u.pn) << 16) + ((((wr * 4 + wc) * 64) + fq * 16 + fr) << 4);
#pragma unroll
        for (int ai = 0; ai < 2; ++ai) {
#pragma unroll
            for (int m = 0; m < 4; ++m) { const int so = (ai * 4 + m) << 13;
                const u32x4 ga = *(const u32x4*)(gp + so), gb = *(const u32x4*)(gp + ((size_t)8 << 16) + so);
                rs4(acc[ai][0][m][0], ga.x, gb.x); rs4(acc[ai][0][m][1], ga.y, gb.y); rs4(acc[ai][1][m][0], ga.z, gb.z); rs4(acc[ai][1][m][1], ga.w, gb.w); }
            asm volatile("" ::: "memory"); }
        asm volatile("s_waitcnt vmcnt(0)" ::: "memory");
    }
    static __device__ __forceinline__ unsigned fin4(const f32x4 v, unsigned g, bool hi) {
        const float s = 1.0f / 255.0f;
        return hi ? cvt_pk_bf16(v[2] * (fl(ub2(g)) * s), v[3] * (fl(ub3(g)) * s)) : cvt_pk_bf16(v[0] * (fl(ub0(g)) * s), v[1] * (fl(ub1(g)) * s)); }
    __device__ __forceinline__ void operator()(const f32x4 (&acc)[2][2][4][2], const Unit& u, int wr, int wc, int fr, int fq) const {
        asm volatile("" : "+v"(fr), "+v"(fq));
        const int row0 = u.pm * BM + wr * 64 + fr, col0 = u.pn * BM + wc * 32 + 8 * fq;
        const unsigned char* gp = Gt + ((size_t)(u.pm * GT_COLS + 16 + u.pn) << 16) + ((((wr * 4 + wc) * 64) + fq * 16 + fr) << 4);
#pragma unroll
        for (int ai = 0; ai < 2; ++ai)
#pragma unroll
            for (int m = 0; m < 4; ++m) { const size_t r = (size_t)(row0 + ai * HALF + m * 16);
                const u32x4 g = *(const u32x4*)(gp + ((ai * 4 + m) << 13));
                u32x4 w0, w1;
                w0.x = fin4(acc[ai][0][m][0], g.x, false); w0.y = fin4(acc[ai][0][m][0], g.x, true); w0.z = fin4(acc[ai][0][m][1], g.y, false); w0.w = fin4(acc[ai][0][m][1], g.y, true);
                w1.x = fin4(acc[ai][1][m][0], g.z, false); w1.y = fin4(acc[ai][1][m][0], g.z, true); w1.z = fin4(acc[ai][1][m][1], g.w, false); w1.w = fin4(acc[ai][1][m][1], g.w, true);
                *(u32x4*)(MG + r * DM + col0) = w0; *(u32x4*)(MG + r * DM + col0 + HALF) = w1; }
    }
};

#define DPPZ(srcv, CTRL) __builtin_bit_cast(float, __builtin_amdgcn_mov_dpp(__builtin_bit_cast(int, (float)(srcv)), (CTRL), 0xf, 0xf, true))
#define DPPF(oldv, srcv, CTRL) __builtin_bit_cast(float, __builtin_amdgcn_mov_dpp(__builtin_bit_cast(int, (float)(srcv)), (CTRL), 0xf, 0xf, false))
struct EpiAct {
    static constexpr bool PERM = true, HAS_MID = false, PIPE = false;
    bf16* ACT; float* EA; float* EU; const float* cw; LAS float* X;
    __device__ __forceinline__ void operator()(const f32x4 (&acc)[2][2][4][2], const Unit& u, int wr, int wc, int fr, int fq) const {
        asm volatile("" : "+v"(fr), "+v"(fq));
        const int cl = wc * 32 + 8 * fq;
        const int cbase = u.pn * 128 + cl;
        float w0[8], w1[8], w2[8];
        { const f32x4 t0 = *(const f32x4*)(cw + cbase), t1 = *(const f32x4*)(cw + cbase + 4), t2 = *(const f32x4*)(cw + DFF + cbase), t3 = *(const f32x4*)(cw + DFF + cbase + 4),
                      t4 = *(const f32x4*)(cw + 2 * DFF + cbase), t5 = *(const f32x4*)(cw + 2 * DFF + cbase + 4);
#pragma unroll
          for (int j = 0; j < 4; ++j) { w0[j] = t0[j]; w0[4 + j] = t1[j]; w1[j] = t2[j]; w1[4 + j] = t3[j]; w2[j] = t4[j]; w2[4 + j] = t5[j]; } }
        float w1m[8], w0m[8];
#pragma unroll
        for (int j = 0; j < 8; ++j) { w1m[j] = fr == 0 ? w1[j] : 0.f; w0m[j] = fr < 2 ? w0[j] : 0.f; }
        if (fr >= 14) {
#pragma unroll
            for (int ai = 0; ai < 2; ++ai) { LAS float* xp = X + ((ai * 2 + wr) * 2 + (fr - 14)) * 128 + cl; *(LAS f32x4*)xp = acc[ai][0][3][0]; *(LAS f32x4*)(xp + 4) = acc[ai][0][3][1]; }
            if (wr == 1) { float* ep = EA + ((size_t)u.pm * 4 + (fr - 14)) * DFF + cbase; *(f32x4*)ep = acc[1][0][3][0]; *(f32x4*)(ep + 4) = acc[1][0][3][1]; }
        }
        if (fr < 2 && wr == 0) {
            float* ep = EA + ((size_t)u.pm * 4 + 2 + fr) * DFF + cbase; *(f32x4*)ep = acc[0][0][0][0]; *(f32x4*)(ep + 4) = acc[0][0][0][1];
            float* up = EU + ((size_t)u.pm * 2 + fr) * DFF + cbase; *(f32x4*)up = acc[0][1][0][0]; *(f32x4*)(up + 4) = acc[0][1][0][1];
        }
        asm volatile("s_waitcnt lgkmcnt(0)" ::: "memory"); __builtin_amdgcn_s_barrier(); asm volatile("" ::: "memory");
#pragma unroll
        for (int ai = 0; ai < 2; ++ai) {
            f32x4 pa = {0.f, 0.f, 0.f, 0.f}, pb = {0.f, 0.f, 0.f, 0.f};
            if (fr >= 14 && (wr == 1 || ai == 1)) { const int sai = wr == 1 ? ai : ai - 1, swr = wr == 1 ? 0 : 1;
                const LAS float* xp = X + ((sai * 2 + swr) * 2 + (fr - 14)) * 128 + cl; pa = *(const LAS f32x4*)xp; pb = *(const LAS f32x4*)(xp + 4); }
#pragma unroll
            for (int m = 0; m < 4; ++m) {
                float o[8];
#pragma unroll
                for (int j = 0; j < 8; ++j) {
                    const float cur = j < 4 ? acc[ai][0][m][0][j & 3] : acc[ai][0][m][1][j & 3];
                    const float prv = m == 0 ? (j < 4 ? pa[j & 3] : pb[j & 3]) : (j < 4 ? acc[ai][0][m - 1][0][j & 3] : acc[ai][0][m - 1][1][j & 3]);
                    const float uu = j < 4 ? acc[ai][1][m][0][j & 3] : acc[ai][1][m][1][j & 3];
                    const float r1 = DPPF(0.f, prv, 0x121), r2 = DPPF(0.f, prv, 0x122);
                    const float x1 = DPPZ(cur, 0x111), x2 = DPPZ(cur, 0x112);
                    const float cv = __builtin_fmaf(w1[j], x1, __builtin_fmaf(w0[j], x2, __builtin_fmaf(w1m[j], r1, __builtin_fmaf(w0m[j], r2, w2[j] * cur))));
                    o[j] = gelu_tanh(cv) * uu;
                }
                u32x4 w; w.x = cvt_pk_bf16(o[0], o[1]); w.y = cvt_pk_bf16(o[2], o[3]); w.z = cvt_pk_bf16(o[4], o[5]); w.w = cvt_pk_bf16(o[6], o[7]);
                *(u32x4*)(ACT + (size_t)(u.pm * BM + ai * HALF + wr * 64 + m * 16 + fr) * DFF + cbase) = w;
            }
        }
    }
};

template <class Epi, class Sched, bool ALIGN_EPI, bool F8 = false>
__device__ __forceinline__ void gemm_phase(LAS unsigned char* lds, const Gemm g, const Sched& S, const Epi& E, const int wave_id) {
    int tid_ = wave_id * 64 + lane_id(); asm volatile("" : "+v"(tid_));
    const int tid = tid_, wid = __builtin_amdgcn_readfirstlane(tid >> 6), lane = tid & 63, wr = wid >> 2, wc = wid & 3, fr = lane & 15, fq = lane >> 4;
    const int K = g.K, nt = K / BK;
    unsigned voffA[2], voffB[2];
#pragma unroll
    for (int i = 0; i < 2; ++i) { int R, C; stage_rc(tid * 16 + i * 8192, R, C); const int Rb = Epi::PERM ? ((R & ~31) + perm32(R & 31)) : R;
        voffA[i] = (unsigned)(R * g.lda + C) * 2u; voffB[i] = (unsigned)(Rb * g.ldb + C) * 2u; }
    const unsigned kstep = (unsigned)(BK * 2);
    const unsigned hstepA = (unsigned)HALF * g.lda * 2u, hstepB = (unsigned)HALF * g.ldb * 2u;
    const auto rsA = __builtin_amdgcn_make_buffer_rsrc((void*)g.A, 0, 0x7fffffff, 0x00020000);
    const auto rsB = __builtin_amdgcn_make_buffer_rsrc((void*)g.Bt, 0, 0x7fffffff, 0x00020000);
    const unsigned ldsw = (unsigned)wid * 1024u;
    const int aoff = lds_byte(wr * 64 + fr, fq * 8), boff = lds_byte(wc * 32 + fr, fq * 8);
#define PG8_SA(b, h) (((b) * 2 + (h)) * HTB)
#define PG8_SB(b, h) ((4 + (b) * 2 + (h)) * HTB)
#define PG8_STAGE_A(bufoff, soff, voff) do { _Pragma("unroll") for (int _i = 0; _i < 2; ++_i) \
        __builtin_amdgcn_raw_ptr_buffer_load_lds(rsA, (LAS unsigned*)(lds + (bufoff) + ldsw + _i * 8192), 16, (voff)[_i], (int)(soff), 0, 0); } while (0)
#define PG8_STAGE_B(bufoff, soff, voff) do { _Pragma("unroll") for (int _i = 0; _i < 2; ++_i) \
        __builtin_amdgcn_raw_ptr_buffer_load_lds(rsB, (LAS unsigned*)(lds + (bufoff) + ldsw + _i * 8192), 16, (voff)[_i], (int)(soff), 0, 0); } while (0)
#define PG8_LDA(dst, b, h) do { if constexpr (F8) { _Pragma("unroll") for (int m = 0; m < 2; ++m) dst##8[m] = cat8(*(const LAS bf16x8*)(lds + PG8_SA(b, h) + aoff + m * 2048), *(const LAS bf16x8*)(lds + PG8_SA(b, h) + aoff + m * 2048 + 1024)); } \
        else { _Pragma("unroll") for (int m = 0; m < 4; ++m) _Pragma("unroll") for (int k = 0; k < 2; ++k) dst[m][k] = *(const LAS bf16x8*)(lds + PG8_SA(b, h) + aoff + m * 2048 + k * 1024); } } while (0)
#define PG8_LDA_HI(dst, b, h) do { _Pragma("unroll") for (int m = 0; m < 2; ++m) dst##8[m] = cat8(*(const LAS bf16x8*)(lds + PG8_SA(b, h) + aoff + (m + 2) * 2048), *(const LAS bf16x8*)(lds + PG8_SA(b, h) + aoff + (m + 2) * 2048 + 1024)); } while (0)
#define PG8_LDB(dst, b, h) do { _Pragma("unroll") for (int n = 0; n < 2; ++n) { if constexpr (F8) dst##8[n] = cat8(*(const LAS bf16x8*)(lds + PG8_SB(b, h) + boff + n * 2048), *(const LAS bf16x8*)(lds + PG8_SB(b, h) + boff + n * 2048 + 1024)); \
        else { _Pragma("unroll") for (int k = 0; k < 2; ++k) dst[n][k] = *(const LAS bf16x8*)(lds + PG8_SB(b, h) + boff + n * 2048 + k * 1024); } } } while (0)
#define PG8_MMA(ai, bj, At, Bt) do { __builtin_amdgcn_s_setprio(1); _Pragma("unroll") for (int m = 0; m < 4; ++m) _Pragma("unroll") for (int n = 0; n < 2; ++n) _Pragma("unroll") for (int k = 0; k < 2; ++k) \
        acc[ai][bj][m][n] = __builtin_amdgcn_mfma_f32_16x16x32_bf16(Bt[n][k], At[m][k], acc[ai][bj][m][n], 0, 0, 0); __builtin_amdgcn_s_setprio(0); } while (0)
#define PG8_MMA8H(ai, mb) do { __builtin_amdgcn_s_setprio(1); _Pragma("unroll") for (int m = 0; m < 2; ++m) _Pragma("unroll") for (int n = 0; n < 2; ++n) { \
        acc[ai][0][mb + m][n] = __builtin_amdgcn_mfma_scale_f32_16x16x128_f8f6f4(B08[n], At8[m], acc[ai][0][mb + m][n], 0, 0, 0, sc8, 0, sc8); \
        acc[ai][1][mb + m][n] = __builtin_amdgcn_mfma_scale_f32_16x16x128_f8f6f4(B18[n], At8[m], acc[ai][1][mb + m][n], 0, 0, 0, sc8, 0, sc8); } __builtin_amdgcn_s_setprio(0); } while (0)
#define PG8_MMAB(ai, b, h) do { if constexpr (F8) { PG8_MMA8H(ai, 0); PG8_LDA_HI(At, b, h); PG8_MMA8H(ai, 2); } else { PG8_MMA(ai, 0, At, B0); PG8_MMA(ai, 1, At, B1); } } while (0)
#define PG8_MMA_E(ai, cond, eu, eai) do { __builtin_amdgcn_s_setprio(1); \
        _Pragma("unroll") for (int m = 0; m < 4; ++m) { _Pragma("unroll") for (int n = 0; n < 2; ++n) _Pragma("unroll") for (int k = 0; k < 2; ++k) { \
            acc[ai][0][m][n] = __builtin_amdgcn_mfma_f32_16x16x32_bf16(B0[n][k], At[m][k], acc[ai][0][m][n], 0, 0, 0); \
            acc[ai][1][m][n] = __builtin_amdgcn_mfma_f32_16x16x32_bf16(B1[n][k], At[m][k], acc[ai][1][m][n], 0, 0, 0); } \
            if (cond) { const int l2_ = lane_id(); E.slice(acc, eu, eai, m, wr, wc, l2_ & 15, l2_ >> 4); } } __builtin_amdgcn_s_setprio(0); } while (0)
#define PG8_ZERO_HALF(ai) do { _Pragma("unroll") for (int b_ = 0; b_ < 2; ++b_) _Pragma("unroll") for (int m_ = 0; m_ < 4; ++m_) _Pragma("unroll") for (int n_ = 0; n_ < 2; ++n_) acc[ai][b_][m_][n_] = (f32x4){0.f, 0.f, 0.f, 0.f}; } while (0)
#define PG8_WAIT_V(n) asm volatile("s_waitcnt vmcnt(" #n ")" ::: "memory")
#define PG8_WAIT_L(n) asm volatile("s_waitcnt lgkmcnt(" #n ")" ::: "memory")
#define PG8_BAR __builtin_amdgcn_s_barrier()
#define PG8_SCHED __builtin_amdgcn_sched_barrier(0)
#define PG8_UA(u) (((unsigned)(u).pm * BM * g.lda) * 2u)
#define PG8_UB(u) (((unsigned)(u).pn * BM * g.ldb) * 2u)
    Unit cur, nxt; int ui = 0;
    if (!S.next(0, cur)) return;
    f32x4 acc[2][2][4][2];
#pragma unroll
    for (int a = 0; a < 2; ++a)
#pragma unroll
        for (int b = 0; b < 2; ++b)
#pragma unroll
            for (int m = 0; m < 4; ++m)
#pragma unroll
                for (int n = 0; n < 2; ++n) acc[a][b][m][n] = (f32x4){0.f, 0.f, 0.f, 0.f};
    int sc8 = 0x7f7f7f7f; if constexpr (F8) asm volatile("" : "+s"(sc8));
    bf16x8 At[4][2], B0[2][2], B1[2][2]; v8i32 At8[2], B08[2], B18[2];
    unsigned cA = PG8_UA(cur), cB = PG8_UB(cur);
    PG8_STAGE_B(PG8_SB(0, 0), cB, voffB); PG8_STAGE_B(PG8_SB(0, 1), cB + hstepB, voffB); PG8_STAGE_A(PG8_SA(0, 0), cA, voffA); PG8_STAGE_A(PG8_SA(0, 1), cA + hstepA, voffA);
    if (wr == 1) PG8_BAR;
    PG8_WAIT_V(2); PG8_BAR;
    PG8_STAGE_B(PG8_SB(1, 0), cB + kstep, voffB); PG8_STAGE_A(PG8_SA(1, 0), cA + kstep, voffA); PG8_STAGE_B(PG8_SB(1, 1), cB + hstepB + kstep, voffB);
    PG8_WAIT_V(6); PG8_BAR;
    constexpr bool PIPE = Epi::PIPE && !F8;
    Unit prev = cur;
    for (;;) {
        const bool has_next = S.next(ui + 1, nxt);
        const unsigned nA = has_next ? PG8_UA(nxt) : cA, nB = has_next ? PG8_UB(nxt) : cB;
        for (int t = 0; t < nt; t += 2) {
            const bool last = (t == nt - 2);
            const bool first = PIPE && t == 0 && ui > 0;
            const unsigned a1 = cA + (unsigned)(t + 1) * kstep;
            const unsigned a2 = last ? nA : cA + (unsigned)(t + 2) * kstep, b2 = last ? nB : cB + (unsigned)(t + 2) * kstep;
            const unsigned a3 = a2 + kstep, b3 = b2 + kstep;
            if constexpr (Epi::HAS_MID) { if (t == 16 || t == 32) { if (wr == 0) PG8_BAR; { const int l2 = lane_id(); E.mid(acc, cur, t >> 4, wr, wc, l2 & 15, l2 >> 4); } if (wr == 1) PG8_BAR; } }
            PG8_LDB(B0, 0, 0); PG8_LDB(B1, 0, 1); PG8_SCHED; PG8_LDA(At, 0, 0); PG8_STAGE_A(PG8_SA(1, 1), a1 + hstepA, voffA);
            if (first) { PG8_WAIT_V(16); } else { PG8_WAIT_V(8); } PG8_WAIT_L(0); PG8_BAR;
            if constexpr (PIPE) { PG8_MMA_E(0, first, prev, 1); if (first) PG8_ZERO_HALF(1); } else { PG8_MMAB(0, 0, 0); }
            PG8_BAR; PG8_SCHED;
            PG8_LDA(At, 0, 1); PG8_STAGE_B(PG8_SB(0, 0), b2, voffB); PG8_STAGE_B(PG8_SB(0, 1), b2 + hstepB, voffB); PG8_STAGE_A(PG8_SA(0, 0), a2, voffA);
            if (first) { PG8_WAIT_V(16); } else { PG8_WAIT_V(8); } PG8_WAIT_L(0); PG8_BAR; PG8_MMAB(1, 0, 1); PG8_BAR; PG8_SCHED;
            PG8_LDB(B0, 1, 0); PG8_LDB(B1, 1, 1); PG8_SCHED; PG8_LDA(At, 1, 0); PG8_STAGE_A(PG8_SA(0, 1), a2 + hstepA, voffA);
            if (first) { PG8_WAIT_V(16); } else { PG8_WAIT_V(8); } PG8_WAIT_L(0); PG8_BAR; PG8_MMAB(0, 1, 0); PG8_BAR; PG8_SCHED;
            PG8_LDA(At, 1, 1); PG8_STAGE_B(PG8_SB(1, 0), b3, voffB); PG8_STAGE_B(PG8_SB(1, 1), b3 + hstepB, voffB); PG8_STAGE_A(PG8_SA(1, 0), a3, voffA);
            PG8_WAIT_V(8); PG8_WAIT_L(0); PG8_BAR;
            if constexpr (PIPE) { PG8_MMA_E(1, last, cur, 0); if (last) PG8_ZERO_HALF(0); } else { PG8_MMAB(1, 1, 1); }
            PG8_BAR; PG8_SCHED;
        }
        if constexpr (PIPE) {
            if (!has_next) { const int l2 = lane_id();
#pragma unroll
                for (int m = 0; m < 4; ++m) E.slice(acc, cur, 1, m, wr, wc, l2 & 15, l2 >> 4);
                break; }
            prev = cur; cur = nxt; cA = nA; cB = nB; ++ui;
        } else {
        if constexpr (ALIGN_EPI) { if (wr == 0) PG8_BAR; }
        { const int l2 = lane_id(); E(acc, cur, wr, wc, l2 & 15, l2 >> 4); }
        if (!has_next) break;
#pragma unroll
        for (int a = 0; a < 2; ++a)
#pragma unroll
            for (int b = 0; b < 2; ++b)
#pragma unroll
                for (int m = 0; m < 4; ++m)
#pragma unroll
                    for (int n = 0; n < 2; ++n) acc[a][b][m][n] = (f32x4){0.f, 0.f, 0.f, 0.f};
        cur = nxt; cA = nA; cB = nB; ++ui;
        if constexpr (ALIGN_EPI) { if (wr == 1) PG8_BAR; }
        }
    }
    PG8_WAIT_V(0);
    if constexpr (!ALIGN_EPI || PIPE) { if (wr == 0) PG8_BAR; }
    PG8_BAR;
#undef PG8_SA
#undef PG8_SB
#undef PG8_STAGE_A
#undef PG8_STAGE_B
#undef PG8_LDA
#undef PG8_LDB
#undef PG8_MMA
#undef PG8_MMA8H
#undef PG8_MMAB
#undef PG8_MMA_E
#undef PG8_ZERO_HALF
#undef PG8_LDA_HI
#undef PG8_WAIT_V
#undef PG8_WAIT_L
#undef PG8_BAR
#undef PG8_SCHED
#undef PG8_UA
#undef PG8_UB
}
}

#define XB_TMO      128
#define XB_XCNT(j)  (256  + 64 * (j))
#define XB_XSUB(j)  (1280 + 64 * (j))
#define XB_XGEN(j)  (2304 + 64 * (j))
#define XB_TOP      3328
#define XB_TOPGEN   3392
#define XCD_BAR_WORDS 3456
#define XB_SPIN_CAP (1u << 18)
__device__ __forceinline__ unsigned xb_ld(unsigned* p)              { return __hip_atomic_load(p, __ATOMIC_RELAXED, __HIP_MEMORY_SCOPE_AGENT); }
__device__ __forceinline__ unsigned xb_add(unsigned* p, unsigned v) { return __hip_atomic_fetch_add(p, v, __ATOMIC_RELAXED, __HIP_MEMORY_SCOPE_AGENT); }
__device__ __forceinline__ unsigned xb_xcc_id() { return (unsigned)__builtin_amdgcn_s_getreg((3 << 11) | 20) & 0xFu; }
#define XB_SPIN(cond, bar) do { unsigned _sp = 0; while (cond) { __builtin_amdgcn_s_sleep(1); \
    if ((++_sp & 255u) == 0u) { if (xb_ld(&(bar)[XB_TMO])) break; if (_sp > XB_SPIN_CAP) { atomicAdd(&(bar)[XB_TMO], 1u); break; } } } } while (0)
struct XcdBarrier { unsigned* bar; unsigned x; volatile LAS unsigned* st; };
__device__ __forceinline__ XcdBarrier xcd_barrier_post(unsigned* bar, volatile LAS unsigned* st) {
    XcdBarrier b; b.bar = bar; b.x = xb_xcc_id(); b.st = st;
    if (threadIdx.x == 0) (void)xb_add(&bar[XB_XCNT(b.x)], 1u);
    return b;
}
__device__ __forceinline__ void xcd_barrier_complete(unsigned* bar, unsigned x, unsigned& nloc, unsigned& nx) {
    const unsigned G = gridDim.x * gridDim.y * gridDim.z;
    unsigned sum, cnt, mine, sp = 0u;
    for (;;) {
        sum = 0u; cnt = 0u; mine = 0u;
#pragma unroll
        for (unsigned j = 0; j < 16; ++j) { const unsigned c = xb_ld(&bar[XB_XCNT(j)]); sum += c; cnt += (c > 0u) ? 1u : 0u; mine = (j == x) ? c : mine; }
        if (sum == G) break;
        __builtin_amdgcn_s_sleep(1);
        if ((++sp & 255u) == 0u) { if (xb_ld(&bar[XB_TMO])) break; if (sp > XB_SPIN_CAP) { atomicAdd(&bar[XB_TMO], 1u); break; } }
    }
    nloc = mine > 0u ? mine : 1u; nx = cnt > 0u ? cnt : 1u;
}
__device__ __forceinline__ void xcd_barrier(const XcdBarrier& b, const bool leader) {
    asm volatile("s_waitcnt vmcnt(0)" ::: "memory");
    __syncthreads();
    if (leader) {
        unsigned* bar = b.bar;
        __builtin_amdgcn_s_waitcnt(0);
        unsigned nloc = b.st[0], nx = b.st[1];
        if (nloc == 0u) { xcd_barrier_complete(bar, b.x, nloc, nx); b.st[0] = nloc; b.st[1] = nx; }
        const unsigned old = xb_add(&bar[XB_XSUB(b.x)], 1u);
        const unsigned gen = old / nloc;
        if (old + 1u == (gen + 1u) * nloc) {
            __builtin_amdgcn_fence(__ATOMIC_RELEASE, "agent");
            asm volatile("s_waitcnt vmcnt(0)" ::: "memory");
            const unsigned og = xb_add(&bar[XB_TOP], 1u);
            const unsigned tg = og / nx;
            if (og + 1u == (tg + 1u) * nx) xb_add(&bar[XB_TOPGEN], 1u);
            else XB_SPIN(xb_ld(&bar[XB_TOPGEN]) == tg, bar);
            __builtin_amdgcn_fence(__ATOMIC_ACQUIRE, "agent");
            xb_add(&bar[XB_XGEN(b.x)], 1u);
            asm volatile("s_waitcnt vmcnt(0)" ::: "memory");
        } else {
            XB_SPIN(xb_ld(&bar[XB_XGEN(b.x)]) == gen, bar);
            __builtin_amdgcn_fence(__ATOMIC_ACQUIRE, "agent");
            asm volatile("s_waitcnt vmcnt(0)" ::: "memory");
        }
    }
    __syncthreads();
}

constexpr int NWAVES = 8, NTHREADS = 512;
constexpr int RING_BYTES = 131072, LDSCTL_OFF = 139264, MISC_OFF = LDSCTL_OFF + 320, XCH_OFF = LDSCTL_OFF + 1024, LDS_BYTES = 147456;
constexpr int NPL = 12, N_PHASES = 1 + NPL * DEPTH;

struct Args { const float* in[17]; float* out; unsigned char* ws; int ph_lo, ph_hi; };
static_assert(sizeof(Args) == 17 * 8 + 8 + 8 + 8, "no padding");

struct Frame { LAS unsigned char* lds; int tid, lane, wave, G, gw, ngw; };
typedef __attribute__((address_space(4))) const unsigned char* kptr_t;
__device__ __forceinline__ kptr_t kbase() { kptr_t p = (kptr_t)__builtin_amdgcn_kernarg_segment_ptr(); asm volatile("" : "+s"(p)); return p; }
__device__ __forceinline__ const float* kin(int i) { return *(const float* const __attribute__((address_space(4)))*)(kbase() + 8 * i); }
__device__ __forceinline__ float* kout() { return *(float* const __attribute__((address_space(4)))*)(kbase() + 136); }
__device__ __forceinline__ unsigned char* kws() { return *(unsigned char* const __attribute__((address_space(4)))*)(kbase() + 144); }
__device__ __forceinline__ void refresh(Frame& F) { int t = F.wave * 64 + lane_id(); asm volatile("" : "+v"(t)); F.tid = t; F.lane = t & 63; F.gw = blockIdx.x * 8 + F.wave; }
enum { I_X = 0, I_META, I_NPM, I_NQM, I_NPF, I_NQF, I_WIN, I_BIF, I_GAIN, I_CMW, I_PW, I_PS, I_WBR, I_WOUT, I_WFFI, I_FCW, I_WFFO };

constexpr float W8_SCALE = 128.0f;
constexpr int WT_LD = 65, WT_BYTES = 64 * WT_LD * 4;
static_assert(8 * WT_BYTES <= LDSCTL_OFF, "weight tiles");
__device__ __forceinline__ void transpose_item64(const float* src, int ldw, unsigned char* dst, int ldb, bool f8, LAS float* scr, int lane) {
    const float* wp = src + lane;
    float v[64];
#pragma unroll
    for (int i = 0; i < 64; ++i) v[i] = __builtin_nontemporal_load(wp + (size_t)i * ldw);
#pragma unroll
    for (int i = 0; i < 64; ++i) scr[i * WT_LD + lane] = v[i];
    LDS_WAIT(); asm volatile("" ::: "memory");
    const int c = lane & 7;
#pragma unroll
    for (int j = 0; j < 8; ++j) { const int n = (lane >> 3) + 8 * j; const LAS float* s = scr + (8 * c) * WT_LD + n;
        if (!f8) { u32x4 o; o.x = pk2(s[0 * WT_LD], s[1 * WT_LD]); o.y = pk2(s[2 * WT_LD], s[3 * WT_LD]); o.z = pk2(s[4 * WT_LD], s[5 * WT_LD]); o.w = pk2(s[6 * WT_LD], s[7 * WT_LD]);
            *(u32x4*)(dst + (size_t)n * ldb + 16 * c) = o; }
        else { int p0 = 0, p1 = 0;
            p0 = __builtin_amdgcn_cvt_pk_fp8_f32(s[0 * WT_LD] * W8_SCALE, s[1 * WT_LD] * W8_SCALE, p0, false); p0 = __builtin_amdgcn_cvt_pk_fp8_f32(s[2 * WT_LD] * W8_SCALE, s[3 * WT_LD] * W8_SCALE, p0, true);
            p1 = __builtin_amdgcn_cvt_pk_fp8_f32(s[4 * WT_LD] * W8_SCALE, s[5 * WT_LD] * W8_SCALE, p1, false); p1 = __builtin_amdgcn_cvt_pk_fp8_f32(s[6 * WT_LD] * W8_SCALE, s[7 * WT_LD] * W8_SCALE, p1, true);
            u32x2 q; q.x = (unsigned)p0; q.y = (unsigned)p1; *(u32x2*)(dst + (size_t)n * ldb + 8 * c) = q; } }
    LDS_WAIT(); asm volatile("" ::: "memory");
}
__device__ __forceinline__ void weights_phase(Frame& F, int l) {
    LAS float* scr = (LAS float*)(F.lds + F.wave * WT_BYTES);
    unsigned char* ws = kws();
    bf16* Bt_in = (bf16*)(ws + WS_W + W_IN); bf16* Bt_br = (bf16*)(ws + WS_W + W_BR); bf16* Bt_out = (bf16*)(ws + WS_W + W_OUT); bf16* Bt_ffi = (bf16*)(ws + WS_W + W_FFI); bf16* Bt_ffo = (bf16*)(ws + WS_W + W_FFO);
    const float* w_in = kin(I_WIN) + (size_t)l * DM * INCOLS;
    const float* w_br = kin(I_WBR) + (size_t)l * 3 * MIXW * DM;
    const float* w_out = kin(I_WOUT) + (size_t)l * DM * DM;
    const float* w_ffi = kin(I_WFFI) + (size_t)l * DM * 2 * DFF;
    const float* w_ffo = kin(I_WFFO) + (size_t)l * DFF * DM;
    constexpr int G_IN = NIN / 64 + 1;
    constexpr int I_IN = G_IN * (DM / 64), I_BR = (DM / 64) * (3072 / 64), I_OUT = (DM / 64) * (DM / 64), I_FFI = (2 * DFF / 64) * (DM / 64), I_FFO = (DM / 64) * (DFF / 64);
    constexpr int NITEMS = I_IN + I_BR + I_OUT + I_FFI + I_FFO;
    for (int it = F.gw; it < NITEMS; it += F.ngw) {
        int r = it;
        if (r < I_IN) { const int kb = r / G_IN, nb = r % G_IN; const int drow = nb * 64, k0 = kb * 64;
            if (drow >= ZPU && drow < ZG) continue;
            const int scol = drow < 4096 ? drow : (drow < NIN ? drow + 16 : 4096);
            if (drow >= ZG && drow < NIN) { transpose_item64(w_in + (size_t)k0 * INCOLS + scol, INCOLS, (unsigned char*)(Bt_in + (size_t)ZG * DM) + (size_t)(drow - ZG) * DM + k0, DM, true, scr, F.lane); continue; }
            transpose_item64(w_in + (size_t)k0 * INCOLS + scol, INCOLS, (unsigned char*)Bt_in + ((size_t)drow * DM + k0) * 2, DM * 2, false, scr, F.lane); continue; } r -= I_IN;
        if (r < I_BR) { const int nblk = DM / 64, kb = r / nblk, nb = r % nblk; transpose_item64(w_br + (size_t)kb * 64 * DM + nb * 64, DM, (unsigned char*)Bt_br + ((size_t)nb * 64 * 3072 + kb * 64) * 2, 3072 * 2, false, scr, F.lane); continue; } r -= I_BR;
        if (r < I_OUT) { const int nblk = DM / 64, kb = r / nblk, nb = r % nblk; transpose_item64(w_out + (size_t)kb * 64 * DM + nb * 64, DM, (unsigned char*)Bt_out + ((size_t)nb * 64 * DM + kb * 64) * 2, DM * 2, false, scr, F.lane); continue; } r -= I_OUT;
        if (r < I_FFI) { const int nblk = 2 * DFF / 64, kb = r / nblk, nb = r % nblk; const int drow = nb * 64, tile = drow >> 8, wq = drow & 255;
            const int scol = wq < 128 ? tile * 128 + wq : DFF + tile * 128 + (wq - 128);
            transpose_item64(w_ffi + (size_t)kb * 64 * 2 * DFF + scol, 2 * DFF, (unsigned char*)Bt_ffi + ((size_t)drow * DM + kb * 64) * 2, DM * 2, false, scr, F.lane); continue; } r -= I_FFI;
        { const int nblk = DM / 64, kb = r / nblk, nb = r % nblk; transpose_item64(w_ffo + (size_t)kb * 64 * DM + nb * 64, DM, (unsigned char*)Bt_ffo + ((size_t)nb * 64 * DFF + kb * 64) * 2, DFF * 2, false, scr, F.lane); }
    }
    __syncthreads();
    const float* pw = kin(I_PW) + (size_t)l * 4 * 256 * 256; const float* ps = kin(I_PS) + (size_t)l * MIXW;
    LAS float* tile = (LAS float*)F.lds;
    for (int it = blockIdx.x; it < 4 * (DM / 32); it += F.G) {
        const int g = it & 3, k0 = (it >> 2) * 32;
        for (int e = F.tid; e < 32 * 256; e += NTHREADS) { const int kk = e >> 8, j = e & 255; tile[e] = w_in[(size_t)(k0 + kk) * INCOLS + 7184 + g * 256 + j]; }
        __syncthreads();
        const int c = F.tid & 255, kh = F.tid >> 8;
        float acc[16];
#pragma unroll
        for (int i = 0; i < 16; ++i) acc[i] = 0.f;
        for (int j = 0; j < 256; j += 4) { const float* pp = pw + ((size_t)g * 256 + j) * 256 + c; const float wa = pp[0], wb = pp[256], wc_ = pp[512], wd = pp[768];
#pragma unroll
            for (int i = 0; i < 16; ++i) { const f32x4 t = *(const LAS f32x4*)(tile + (kh * 16 + i) * 256 + j); acc[i] += (t[0] * wa + t[1] * wb) + (t[2] * wc_ + t[3] * wd); } }
        const float sc = ps[g * 256 + c];
        u32x4 o0, o1;
        o0.x = pk2(acc[0] * sc, acc[1] * sc); o0.y = pk2(acc[2] * sc, acc[3] * sc); o0.z = pk2(acc[4] * sc, acc[5] * sc); o0.w = pk2(acc[6] * sc, acc[7] * sc);
        o1.x = pk2(acc[8] * sc, acc[9] * sc); o1.y = pk2(acc[10] * sc, acc[11] * sc); o1.z = pk2(acc[12] * sc, acc[13] * sc); o1.w = pk2(acc[14] * sc, acc[15] * sc);
        bf16* dst = Bt_in + (size_t)(ZPU + g * 256 + c) * DM + k0 + kh * 16;
        *(u32x4*)dst = o0; *(u32x4*)(dst + 8) = o1;
        __syncthreads();
    }
}

__device__ __forceinline__ void store_h_row(bf16* hrow, unsigned char* h8row, const f32x4 (&v)[8], float r, const float* g, int lane) {
#pragma unroll
    for (int j = 0; j < 4; ++j) { const f32x4 ga = *(const f32x4*)(g + 8 * lane + 512 * j), gb = *(const f32x4*)(g + 8 * lane + 512 * j + 4);
        const f32x4 a = v[2 * j] * r * ga, b = v[2 * j + 1] * r * gb;
        u32x4 w; w.x = pk2(a[0], a[1]); w.y = pk2(a[2], a[3]); w.z = pk2(b[0], b[1]); w.w = pk2(b[2], b[3]);
        *(u32x4*)(hrow + 8 * lane + 512 * j) = w;
        if (h8row) { int p0 = 0, p1 = 0;
            p0 = __builtin_amdgcn_cvt_pk_fp8_f32(a[0], a[1], p0, false); p0 = __builtin_amdgcn_cvt_pk_fp8_f32(a[2], a[3], p0, true);
            p1 = __builtin_amdgcn_cvt_pk_fp8_f32(b[0], b[1], p1, false); p1 = __builtin_amdgcn_cvt_pk_fp8_f32(b[2], b[3], p1, true);
            u32x2 q; q.x = (unsigned)p0; q.y = (unsigned)p1; *(u32x2*)(h8row + 8 * lane + 512 * j) = q; } }
}
__device__ __forceinline__ float sumsq8(const f32x4 (&v)[8]) { float s = 0.f;
#pragma unroll
    for (int j = 0; j < 8; ++j) s += (v[j][0] * v[j][0] + v[j][1] * v[j][1]) + (v[j][2] * v[j][2] + v[j][3] * v[j][3]);
    return s; }
__device__ __forceinline__ void norm0_phase(Frame& F) {
    const float* x = kin(I_X); const float* meta = kin(I_META); const float* g = kin(I_NPM); unsigned char* ws = kws(); bf16* H = (bf16*)(ws + WS_H); unsigned char* H8 = ws + WS_H8;
    for (int row = F.gw; row < MT; row += F.ngw) {
        const float* xr = row < MR ? x + (size_t)row * DM : meta + (size_t)(row - MR) * DM;
        f32x4 v[8];
#pragma unroll
        for (int j = 0; j < 4; ++j) { v[2 * j] = *(const f32x4*)(xr + 8 * F.lane + 512 * j); v[2 * j + 1] = *(const f32x4*)(xr + 8 * F.lane + 512 * j + 4); }
        const float r = rsqrtf(wave_sum(sumsq8(v)) * (1.0f / DM) + RMS_EPS);
        store_h_row(H + (size_t)row * DM, H8 + (size_t)row * DM, v, r, g, F.lane);
    }
}
__device__ __forceinline__ void nrn_phase(Frame& F, const bf16* Y, const void* xin_real, bool in_bf16, const float* xin_meta, void* xout_real, bool out_bf16,
                                          const float* g_post, const float* g_next, bool want_h8) {
    unsigned char* ws = kws(); float* XM = (float*)(ws + WS_XM); bf16* H = (bf16*)(ws + WS_H); unsigned char* H8 = ws + WS_H8;
    for (int row = F.gw; row < MT; row += F.ngw) {
        const bf16* yr = Y + (size_t)row * DM;
        f32x4 y[8], x[8];
#pragma unroll
        for (int j = 0; j < 4; ++j) { const u32x4 w = *(const u32x4*)(yr + 8 * F.lane + 512 * j);
            y[2 * j] = (f32x4){bflo(w.x), bfhi(w.x), bflo(w.y), bfhi(w.y)}; y[2 * j + 1] = (f32x4){bflo(w.z), bfhi(w.z), bflo(w.w), bfhi(w.w)}; }
        if (row < MR && in_bf16) { const bf16* xr = (const bf16*)xin_real + (size_t)row * DM;
#pragma unroll
            for (int j = 0; j < 4; ++j) { const u32x4 w = *(const u32x4*)(xr + 8 * F.lane + 512 * j);
                x[2 * j] = (f32x4){bflo(w.x), bfhi(w.x), bflo(w.y), bfhi(w.y)}; x[2 * j + 1] = (f32x4){bflo(w.z), bfhi(w.z), bflo(w.w), bfhi(w.w)}; } }
        else { const float* xr = row < MR ? (const float*)xin_real + (size_t)row * DM : xin_meta + (size_t)(row - MR) * DM;
#pragma unroll
            for (int j = 0; j < 4; ++j) { x[2 * j] = *(const f32x4*)(xr + 8 * F.lane + 512 * j); x[2 * j + 1] = *(const f32x4*)(xr + 8 * F.lane + 512 * j + 4); } }
        const float r = rsqrtf(wave_sum(sumsq8(y)) * (1.0f / DM) + RMS_EPS);
#pragma unroll
        for (int j = 0; j < 4; ++j) { const f32x4 ga = *(const f32x4*)(g_post + 8 * F.lane + 512 * j), gb = *(const f32x4*)(g_post + 8 * F.lane + 512 * j + 4);
            x[2 * j] = x[2 * j] + y[2 * j] * r * ga; x[2 * j + 1] = x[2 * j + 1] + y[2 * j + 1] * r * gb; }
        if (row < MR && out_bf16) { bf16* xo = (bf16*)xout_real + (size_t)row * DM;
#pragma unroll
            for (int j = 0; j < 4; ++j) { u32x4 w; w.x = pk2(x[2 * j][0], x[2 * j][1]); w.y = pk2(x[2 * j][2], x[2 * j][3]); w.z = pk2(x[2 * j + 1][0], x[2 * j + 1][1]); w.w = pk2(x[2 * j + 1][2], x[2 * j + 1][3]);
                *(u32x4*)(xo + 8 * F.lane + 512 * j) = w; } }
        else { float* xo = row < MR ? (float*)xout_real + (size_t)row * DM : XM + (size_t)(row - MR) * DM;
#pragma unroll
            for (int j = 0; j < 4; ++j) { *(f32x4*)(xo + 8 * F.lane + 512 * j) = x[2 * j]; *(f32x4*)(xo + 8 * F.lane + 512 * j + 4) = x[2 * j + 1]; } }
        if (g_next) { const float r2 = rsqrtf(wave_sum(sumsq8(x)) * (1.0f / DM) + RMS_EPS); store_h_row(H + (size_t)row * DM, want_h8 ? H8 + (size_t)row * DM : (unsigned char*)nullptr, x, r2, g_next, F.lane); }
    }
}

__device__ __forceinline__ f32x4 thin_tile(const bf16* A, int lda, const bf16* Bt, int ldb, int K, int lane) {
    const bf16* ap = A + (size_t)(lane & 15) * lda + 8 * (lane >> 4);
    const bf16* bp = Bt + (size_t)(lane & 15) * ldb + 8 * (lane >> 4);
    f32x4 acc = {0.f, 0.f, 0.f, 0.f};
#pragma unroll 8
    for (int k = 0; k < K; k += 32) { const bf16x8 a = *(const bf16x8*)(ap + k); const bf16x8 b = *(const bf16x8*)(bp + k); acc = __builtin_amdgcn_mfma_f32_16x16x32_bf16(a, b, acc, 0, 0, 0); }
    return acc;
}

__device__ __forceinline__ f32x4 thin_part(const bf16* A, int lda, const bf16* Bt, int ldb, int k0, int klen, int lane) {
    const bf16* ap = A + (size_t)(lane & 15) * lda + 8 * (lane >> 4) + k0;
    const bf16* bp = Bt + (size_t)(lane & 15) * ldb + 8 * (lane >> 4) + k0;
    f32x4 acc = {0.f, 0.f, 0.f, 0.f};
#pragma unroll 16
    for (int k = 0; k < klen; k += 32) { const bf16x8 a = *(const bf16x8*)(ap + k); const bf16x8 b = *(const bf16x8*)(bp + k); acc = __builtin_amdgcn_mfma_f32_16x16x32_bf16(a, b, acc, 0, 0, 0); }
    return acc;
}
__device__ __forceinline__ f32x4 thin_part8(const unsigned char* A8, int lda, const unsigned char* B8, int ldb, int k0, int klen, int lane) {
    const unsigned char* ap = A8 + (size_t)(lane & 15) * lda + 32 * (lane >> 4) + k0;
    const unsigned char* bp = B8 + (size_t)(lane & 15) * ldb + 32 * (lane >> 4) + k0;
    f32x4 acc = {0.f, 0.f, 0.f, 0.f};
#pragma unroll 8
    for (int k = 0; k < klen; k += 128) { const pg8::v8i32 a = *(const pg8::v8i32*)(ap + k); const pg8::v8i32 b = *(const pg8::v8i32*)(bp + k);
        acc = __builtin_amdgcn_mfma_scale_f32_16x16x128_f8f6f4(a, b, acc, 0, 0, 0, 0x7f7f7f7f, 0, 0x7f7f7f7f); }
    return acc;
}
template <int NC, int KS, class Part, class Epi>
__device__ __forceinline__ void thin_wg(Frame& F, int ntiles, LAS f32x4* red, const Part& part, const Epi& epi) {
    static_assert(NC * KS == 8, "8 waves");
    const int sub = F.wave / KS, ks = F.wave % KS;
    for (int it = blockIdx.x; it * NC < ntiles; it += F.G) {
        const int ti = it * NC + sub;
        f32x4 acc = {0.f, 0.f, 0.f, 0.f};
        if (ti < ntiles) acc = part(ti, ks);
        red[F.wave * 64 + F.lane] = acc;
        __syncthreads();
        if (ks == 0 && ti < ntiles) {
#pragma unroll
            for (int j = 1; j < KS; ++j) acc += red[(F.wave + j) * 64 + F.lane];
            epi(ti, acc);
        }
        __syncthreads();
    }
}

typedef short s16x4 __attribute__((ext_vector_type(4)));
typedef short v4i16_t __attribute__((ext_vector_type(4)));
constexpr int DVE = 144, KS_RS = 272, VS_RS = 304, PM_RS = 144, RING_BYTES_C = 131072;
constexpr int NUNIT = 8 + NB * NHEAD * 64;
constexpr int USLOT = DVE * DHEAD;
constexpr size_t WS_SC = WS_IF + 1536 * 1024;
constexpr size_t WS_MC = WS_IF + 1792 * 1024;
static_assert((size_t)MT * 16 * 4 <= 1536 * 1024 && (size_t)NUNIT * USLOT * 2 <= 80 * MiB, "mlstm scratch");
__device__ __forceinline__ s16x4 tr16(const LAS unsigned char* p) { return __builtin_bit_cast(s16x4, __builtin_amdgcn_ds_read_tr16_b64_v4i16((LAS v4i16_t*)p)); }
__device__ __forceinline__ bf16x8 tr_frag(const LAS unsigned char* img, int RS, int ks, int c0, int lane) {
    const int g = lane >> 4, q = (lane & 15) >> 2, p = lane & 3;
    const LAS unsigned char* a = img + (32 * ks + 8 * g + q) * RS + c0 * 2 + 8 * p;
    const s16x4 lo = tr16(a), hi = tr16(a + 4 * RS);
    return __builtin_shufflevector(lo, hi, 0, 1, 2, 3, 4, 5, 6, 7);
}
__device__ __forceinline__ void unpack8(const u32x4 w, float (&f)[8]) { f[0] = bflo(w.x); f[1] = bfhi(w.x); f[2] = bflo(w.y); f[3] = bfhi(w.y); f[4] = bflo(w.z); f[5] = bfhi(w.z); f[6] = bflo(w.w); f[7] = bfhi(w.w); }
__device__ __forceinline__ u32x4 pack8(const float (&f)[8]) { u32x4 w; w.x = pk2(f[0], f[1]); w.y = pk2(f[2], f[3]); w.z = pk2(f[4], f[5]); w.w = pk2(f[6], f[7]); return w; }
__device__ __forceinline__ float logsigmoidf_(float x) {
    const float e = __builtin_amdgcn_exp2f(-1.4426950408889634f * fabsf(x));
    return fminf(x, 0.f) - 0.6931471805599453f * __builtin_amdgcn_logf(1.0f + e);
}
#define DPPX(oldv, srcv, CTRL, RM) __builtin_bit_cast(float, __builtin_amdgcn_update_dpp(__builtin_bit_cast(int, (float)(oldv)), __builtin_bit_cast(int, (float)(srcv)), (CTRL), (RM), 0xf, false))
__device__ __forceinline__ float wave_scan_add(float x, int) {
    x += DPPX(0.f, x, 0x111, 0xf); x += DPPX(0.f, x, 0x112, 0xf); x += DPPX(0.f, x, 0x114, 0xf); x += DPPX(0.f, x, 0x118, 0xf);
    x += DPPX(0.f, x, 0x142, 0xa); x += DPPX(0.f, x, 0x143, 0xc);
    return x;
}
__device__ __forceinline__ float wave_scan_max(float x, int) {
    const float ninf = -INFINITY;
    x = fmaxf(x, DPPX(ninf, x, 0x111, 0xf)); x = fmaxf(x, DPPX(ninf, x, 0x112, 0xf)); x = fmaxf(x, DPPX(ninf, x, 0x114, 0xf)); x = fmaxf(x, DPPX(ninf, x, 0x118, 0xf));
    x = fmaxf(x, DPPX(ninf, x, 0x142, 0xa)); x = fmaxf(x, DPPX(ninf, x, 0x143, 0xc));
    return x;
}
__device__ __forceinline__ void unit_decode(int u, int& b, int& h, int& T, int& row0, int& bh, int& c) {
    if (u < 8) { b = 0; h = u; T = NMETA; row0 = MR; bh = u; c = 0; }
    else { const int v = u - 8; const int c1 = v & 63; bh = v >> 6; h = bh & 7; b = bh >> 3; T = 64; row0 = b * SEQ + c1 * 64; c = c1 + 1; }
}
__device__ __forceinline__ void mlstm_u_phase(Frame& F, int l) {
    unsigned char* ws = kws(); const bf16* Z = (const bf16*)(ws + WS_Z); const float* IFb = (const float*)(ws + WS_IF); const float* b_if = kin(I_BIF);
    bf16* U = (bf16*)(ws + WS_MIX); float* SC = (float*)(ws + WS_SC);
    LAS unsigned char* ksm = F.lds; LAS unsigned char* vsm = F.lds + 64 * KS_RS;
    const int tid = F.tid, lane = F.lane, wave = F.wave;
    for (int u = blockIdx.x; u < NUNIT; u += F.G) {
        int b, h, T, row0, bh, c; unit_decode(u, b, h, T, row0, bh, c);
        const float bi = b_if[(l * 2 + 0) * NHEAD + h], bfv = b_if[(l * 2 + 1) * NHEAD + h];
        float li = 0.f, lfv = 0.f;
        if (lane < T) { li = IFb[(size_t)(row0 + lane) * 16 + h] + bi; lfv = logsigmoidf_(IFb[(size_t)(row0 + lane) * 16 + 8 + h] + bfv); }
        const float bcum = wave_scan_add(lfv, lane);
        const float a = lane < T ? li - bcum : -INFINITY;
        const float amax = __builtin_bit_cast(float, __builtin_amdgcn_readlane(__builtin_bit_cast(int, wave_scan_max(a, lane)), 63));
        const float bT = __builtin_bit_cast(float, __builtin_amdgcn_readlane(__builtin_bit_cast(int, bcum), 63));
        const float wsl = lane < T ? expf(a - amax) : 0.f;
        if (tid == 0) { SC[2 * u] = bT; SC[2 * u + 1] = amax; }
#pragma unroll
        for (int pi = 0; pi < 2; ++pi) {
            const int p = tid + NTHREADS * pi, s = p >> 4, d8 = (p & 15) * 8;
            float wv;
            { const int sb = 4 * wave + 32 * pi; const int wi = __builtin_bit_cast(int, wsl);
              const float r0 = __builtin_bit_cast(float, __builtin_amdgcn_readlane(wi, sb)), r1 = __builtin_bit_cast(float, __builtin_amdgcn_readlane(wi, sb + 1)),
                          r2 = __builtin_bit_cast(float, __builtin_amdgcn_readlane(wi, sb + 2)), r3 = __builtin_bit_cast(float, __builtin_amdgcn_readlane(wi, sb + 3));
              const int k = lane >> 4; wv = k == 0 ? r0 : (k == 1 ? r1 : (k == 2 ? r2 : r3)); }
            u32x4 kv = {0u, 0u, 0u, 0u}, vv = {0u, 0u, 0u, 0u};
            if (s < T) { const bf16* zr = Z + (size_t)(row0 + s) * ZP + h * DHEAD + d8; kv = *(const u32x4*)(zr + ZK); vv = *(const u32x4*)(zr + ZV); }
            *(LAS u32x4*)(ksm + s * KS_RS + d8 * 2) = kv;
            u32x4 sv; sv.x = pk2(bflo(vv.x) * wv, bfhi(vv.x) * wv); sv.y = pk2(bflo(vv.y) * wv, bfhi(vv.y) * wv); sv.z = pk2(bflo(vv.z) * wv, bfhi(vv.z) * wv); sv.w = pk2(bflo(vv.w) * wv, bfhi(vv.w) * wv);
            *(LAS u32x4*)(vsm + s * VS_RS + d8 * 2) = sv;
        }
        if (tid < 64) { const u32x4 o = {f2bf(wsl), 0u, 0u, 0u}; unsigned zz_; asm volatile("v_mov_b32 %0, 0" : "=v"(zz_)); const u32x4 z = {zz_, zz_, zz_, zz_};
            *(LAS u32x4*)(vsm + tid * VS_RS + 256) = o; *(LAS u32x4*)(vsm + tid * VS_RS + 272) = z; }
        __syncthreads();
        const bf16x8 A0 = tr_frag(ksm, KS_RS, 0, 16 * wave, lane), A1 = tr_frag(ksm, KS_RS, 1, 16 * wave, lane);
        bf16* Uu = U + (size_t)u * USLOT;
#pragma unroll
        for (int j = 0; j < 9; ++j) {
            const bf16x8 B0 = tr_frag(vsm, VS_RS, 0, 16 * j, lane), B1 = tr_frag(vsm, VS_RS, 1, 16 * j, lane);
            f32x4 acc = {0.f, 0.f, 0.f, 0.f};
            acc = __builtin_amdgcn_mfma_f32_16x16x32_bf16(A0, B0, acc, 0, 0, 0);
            acc = __builtin_amdgcn_mfma_f32_16x16x32_bf16(A1, B1, acc, 0, 0, 0);
            u32x2 o; o.x = pk2(acc[0], acc[1]); o.y = pk2(acc[2], acc[3]);
            *(u32x2*)(Uu + (16 * j + (lane & 15)) * DHEAD + 16 * wave + 4 * (lane >> 4)) = o;
        }
        __syncthreads();
    }
}
__device__ __forceinline__ void mlstm_scan_phase(Frame& F) {
    unsigned char* ws = kws(); bf16* U = (bf16*)(ws + WS_MIX); const float* SC = (const float*)(ws + WS_SC); float* MC = (float*)(ws + WS_MC);
    constexpr int OPS = USLOT / 8;
    for (int q = blockIdx.x * NTHREADS + F.tid; q < 32 * OPS; q += F.G * NTHREADS) {
        const int bh = q / OPS, idx = q - bh * OPS, h = bh & 7;
        float st[8], m = 0.f;
#pragma unroll
        for (int j = 0; j < 8; ++j) st[j] = 0.f;
        {
            float uf[8]; unpack8(*(const u32x4*)(U + (size_t)h * USLOT + idx * 8), uf); const float bT = SC[2 * h], amax = SC[2 * h + 1];
            if (idx == 0) MC[bh * 65] = 0.f;
            const float m1 = bT + fmaxf(m, amax), dec = expf(bT + m - m1), wu = expf(bT + amax - m1);
#pragma unroll
            for (int j = 0; j < 8; ++j) st[j] = dec * st[j] + wu * uf[j];
            m = m1;
        }
        for (int c0 = 0; c0 < 64; c0 += 16) {
            u32x4 uq[16]; float bT[16], am[16];
#pragma unroll
            for (int i = 0; i < 16; ++i) { const int unit = 8 + bh * 64 + c0 + i; uq[i] = *(const u32x4*)(U + (size_t)unit * USLOT + idx * 8); bT[i] = SC[2 * unit]; am[i] = SC[2 * unit + 1]; }
#pragma unroll
            for (int i = 0; i < 16; ++i) { const int unit = 8 + bh * 64 + c0 + i;
                *(u32x4*)(U + (size_t)unit * USLOT + idx * 8) = pack8(st);
                if (idx == 0) MC[bh * 65 + c0 + i + 1] = m;
                float uf[8]; unpack8(uq[i], uf);
                const float m1 = bT[i] + fmaxf(m, am[i]), dec = expf(bT[i] + m - m1), wu = expf(bT[i] + am[i] - m1);
#pragma unroll
                for (int j = 0; j < 8; ++j) st[j] = dec * st[j] + wu * uf[j];
                m = m1; }
        }
    }
}
#define BAR_LDS() do { asm volatile("s_waitcnt lgkmcnt(0)" ::: "memory"); __builtin_amdgcn_s_barrier(); asm volatile("" ::: "memory"); } while (0)
constexpr int KQ_RS = 272, OL_K = 0, OL_Q = 64 * KQ_RS, OL_C = 2 * 64 * KQ_RS, OL_V = OL_C + DVE * KQ_RS, OL_P = OL_V + 64 * VS_RS, OL_T = OL_P + 64 * PM_RS;
static_assert(OL_T + 8 * 256 <= RING_BYTES_C, "mlstm out LDS");
struct OutRegs { u32x4 pk[2], pq[2], pv[2], pc[5]; float li, xf, mc; };
__device__ __forceinline__ void out_issue(OutRegs& R, int u, int l, const bf16* Z, const float* IFb, const bf16* U, const float* MC, int tid, int lane, int wave) {
    int b, h, T, row0, bh, c; unit_decode(u, b, h, T, row0, bh, c);
    R.mc = u >= 8 ? MC[bh * 65 + c] : 0.f; R.li = 0.f; R.xf = 0.f;
    if (wave == 0 && lane < T) { R.li = IFb[(size_t)(row0 + lane) * 16 + h]; R.xf = IFb[(size_t)(row0 + lane) * 16 + 8 + h]; }
#pragma unroll
    for (int pi = 0; pi < 2; ++pi) { const int p = tid + NTHREADS * pi, s = p >> 4, d8 = (p & 15) * 8;
        R.pk[pi] = (u32x4){0u, 0u, 0u, 0u}; R.pq[pi] = R.pk[pi]; R.pv[pi] = R.pk[pi];
        if (s < T) { const bf16* zr = Z + (size_t)(row0 + s) * ZP + h * DHEAD + d8; R.pk[pi] = *(const u32x4*)(zr + ZK); R.pq[pi] = *(const u32x4*)(zr + ZQ); R.pv[pi] = *(const u32x4*)(zr + ZV); } }
    const bf16* Ct = U + (size_t)u * USLOT;
#pragma unroll
    for (int pi = 0; pi < 5; ++pi) { const int p = tid + NTHREADS * pi; R.pc[pi] = (u32x4){0u, 0u, 0u, 0u}; if (u >= 8 && p < DVE * 16) R.pc[pi] = *(const u32x4*)(Ct + p * 8); }
}
__device__ __forceinline__ void mlstm_out_phase(Frame& F, int l) {
    unsigned char* ws = kws(); const bf16* Z = (const bf16*)(ws + WS_Z); const float* IFb = (const float*)(ws + WS_IF); const float* b_if = kin(I_BIF);
    const bf16* U = (const bf16*)(ws + WS_MIX); const float* MC = (const float*)(ws + WS_MC); bf16* YS = (bf16*)(ws + WS_YS);
    const float* gain = kin(I_GAIN) + (size_t)l * MIXW;
    LAS unsigned char* ksm = F.lds + OL_K; LAS unsigned char* qsm = F.lds + OL_Q; LAS unsigned char* csm = F.lds + OL_C; LAS unsigned char* vsm = F.lds + OL_V; LAS unsigned char* Pm = F.lds + OL_P;
    LAS float* Atab = (LAS float*)(F.lds + OL_T); LAS float* MM = Atab + 64, *IWQ = MM + 64, *EM = IWQ + 64, *DEN = EM + 64, *SS = DEN + 64;
    const int tid = F.tid, lane = F.lane, wave = F.wave;
    const float qscale = 0.08838834764831845f;
    const int tt = wave & 3, js = wave >> 2, g = lane >> 4;
    OutRegs R;
    if ((int)blockIdx.x < NUNIT) out_issue(R, blockIdx.x, l, Z, IFb, U, MC, tid, lane, wave);
    for (int u = blockIdx.x; u < NUNIT; u += F.G) {
        int b, h, T, row0, bh, c; unit_decode(u, b, h, T, row0, bh, c);
        const bool has_state = u >= 8;
        const bool tvalid = 16 * tt < T;
        const int trow = 16 * tt + (lane & 15);
        if (wave == 0) {
            const float bi = b_if[(l * 2 + 0) * NHEAD + h], bfv = b_if[(l * 2 + 1) * NHEAD + h];
            const float lfv = lane < T ? logsigmoidf_(R.xf + bfv) : 0.f;
            const float bcum = wave_scan_add(lfv, lane);
            const float a = lane < T ? R.li + bi - bcum : -INFINITY;
            const float pm = wave_scan_max(a, lane);
            const float mm = fmaxf(R.mc, pm);
            Atab[lane] = a; MM[lane] = mm; IWQ[lane] = expf(R.mc - mm) * qscale; EM[lane] = expf(-(bcum + mm));
        }
#pragma unroll
        for (int pi = 0; pi < 2; ++pi) { const int p = tid + NTHREADS * pi, s = p >> 4, ch = p & 15;
            *(LAS u32x4*)(ksm + s * KQ_RS + ch * 16) = R.pk[pi]; *(LAS u32x4*)(qsm + s * KQ_RS + ch * 16) = R.pq[pi]; *(LAS u32x4*)(vsm + s * VS_RS + ch * 16) = R.pv[pi]; }
#pragma unroll
        for (int pi = 0; pi < 5; ++pi) { const int p = tid + NTHREADS * pi; if (p < DVE * 16) *(LAS u32x4*)(csm + (p >> 4) * KQ_RS + (p & 15) * 16) = R.pc[pi]; }
        if (tid < 64) { const u32x4 o = {tid < T ? 0x3f80u : 0u, 0u, 0u, 0u}; unsigned zz_; asm volatile("v_mov_b32 %0, 0" : "=v"(zz_)); const u32x4 z = {zz_, zz_, zz_, zz_};
            *(LAS u32x4*)(vsm + tid * VS_RS + 256) = o; *(LAS u32x4*)(vsm + tid * VS_RS + 272) = z; }
        BAR_LDS();
        if (u + F.G < NUNIT) out_issue(R, u + F.G, l, Z, IFb, U, MC, tid, lane, wave);
        u32x2 og[5];
#pragma unroll
        for (int jj = 0; jj < 5; ++jj) { const int j = js + 2 * jj; og[jj] = (u32x2){0u, 0u};
            if (tvalid && j < 8) og[jj] = *(const u32x2*)(Z + (size_t)(row0 + trow) * ZP + ZO + h * DHEAD + 16 * j + 4 * g); }
        bf16x8 Q[4];
#pragma unroll
        for (int ks = 0; ks < 4; ++ks) Q[ks] = *(const LAS bf16x8*)(qsm + trow * KQ_RS + 64 * ks + 16 * g);
#pragma unroll
        for (int i = 0; i < 2; ++i) {
            const int ts = 2 * js + i;
            u32x2 outp = {0u, 0u};
            if (tvalid && ts <= tt) {
                f32x4 acc = {0.f, 0.f, 0.f, 0.f};
#pragma unroll
                for (int ks = 0; ks < 4; ++ks) { const bf16x8 Ak = *(const LAS bf16x8*)(ksm + (16 * ts + (lane & 15)) * KQ_RS + 64 * ks + 16 * g); acc = __builtin_amdgcn_mfma_f32_16x16x32_bf16(Ak, Q[ks], acc, 0, 0, 0); }
                const float mmt = MM[trow];
                float pv[4];
#pragma unroll
                for (int i2 = 0; i2 < 4; ++i2) { const int s = 16 * ts + 4 * g + i2; pv[i2] = s <= trow ? acc[i2] * qscale * expf(Atab[s] - mmt) : 0.f; }
                outp.x = pk2(pv[0], pv[1]); outp.y = pk2(pv[2], pv[3]);
            }
            *(LAS u32x2*)(Pm + trow * PM_RS + (16 * ts + 4 * g) * 2) = outp;
        }
        BAR_LDS();
        f32x4 accs[5];
#pragma unroll
        for (int jj = 0; jj < 5; ++jj) accs[jj] = (f32x4){0.f, 0.f, 0.f, 0.f};
        if (tvalid) {
            const bf16x8 PB0 = *(const LAS bf16x8*)(Pm + trow * PM_RS + (8 * g) * 2), PB1 = *(const LAS bf16x8*)(Pm + trow * PM_RS + (32 + 8 * g) * 2);
            const float iwq = IWQ[trow];
#pragma unroll
            for (int jj = 0; jj < 5; ++jj) {
                const int j = js + 2 * jj;
                if (j <= 8) {
                    f32x4 acc = {0.f, 0.f, 0.f, 0.f};
                    if (has_state) {
#pragma unroll
                        for (int ks = 0; ks < 4; ++ks) { const bf16x8 Ac = *(const LAS bf16x8*)(csm + (16 * j + (lane & 15)) * KQ_RS + 64 * ks + 16 * g); acc = __builtin_amdgcn_mfma_f32_16x16x32_bf16(Ac, Q[ks], acc, 0, 0, 0); }
                        acc = acc * iwq;
                    }
                    { const bf16x8 Av = tr_frag(vsm, VS_RS, 0, 16 * j, lane); acc = __builtin_amdgcn_mfma_f32_16x16x32_bf16(Av, PB0, acc, 0, 0, 0); }
                    if (tt >= 2) { const bf16x8 Av = tr_frag(vsm, VS_RS, 1, 16 * j, lane); acc = __builtin_amdgcn_mfma_f32_16x16x32_bf16(Av, PB1, acc, 0, 0, 0); }
                    accs[jj] = acc;
                    if (j == 8 && g == 0) DEN[trow] = acc[0];
                }
            }
        }
        BAR_LDS();
        if (tvalid) {
            const float den = DEN[trow]; const float inv = 1.0f / fmaxf(fabsf(den), EM[trow]);
            float ssp = 0.f;
#pragma unroll
            for (int jj = 0; jj < 5; ++jj) { const int j = js + 2 * jj; if (j < 8) { accs[jj] = accs[jj] * inv; ssp += (accs[jj][0] * accs[jj][0] + accs[jj][1] * accs[jj][1]) + (accs[jj][2] * accs[jj][2] + accs[jj][3] * accs[jj][3]); } }
            ssp += __shfl_xor(ssp, 16); ssp += __shfl_xor(ssp, 32);
            if (g == 0) SS[js * 64 + trow] = ssp;
        }
        BAR_LDS();
        if (tvalid) {
            const float r = rsqrtf((SS[trow] + SS[64 + trow]) * (1.0f / DHEAD) + RMS_EPS);
            bf16* yr = YS + (size_t)(row0 + trow) * 3072 + h * DHEAD + 4 * g;
#pragma unroll
            for (int jj = 0; jj < 5; ++jj) { const int j = js + 2 * jj;
                if (j < 8) { const f32x4 gn = *(const f32x4*)(gain + h * DHEAD + 16 * j + 4 * g);
                    const float y0 = accs[jj][0] * r * gn[0] * sigmoidf_(bflo(og[jj].x)), y1 = accs[jj][1] * r * gn[1] * sigmoidf_(bfhi(og[jj].x));
                    const float y2 = accs[jj][2] * r * gn[2] * sigmoidf_(bflo(og[jj].y)), y3 = accs[jj][3] * r * gn[3] * sigmoidf_(bfhi(og[jj].y));
                    u32x2 w; w.x = pk2(y0, y1); w.y = pk2(y2, y3);
                    *(u32x2*)(yr + 16 * j) = w; } }
        }
        BAR_LDS();
    }
}

__device__ __forceinline__ void mix_phase(Frame& F, int l) {
    unsigned char* ws = kws(); const bf16* Z = (const bf16*)(ws + WS_Z); bf16* YS = (bf16*)(ws + WS_YS);
    const float* cw = kin(I_CMW) + (size_t)l * 3 * MIXW;
    const int sub = F.tid >> 7, tcol = F.tid & 127, c = 8 * tcol, win = 2 << (tcol >> 5);
    float w0[8], w1[8], w2[8];
#pragma unroll
    for (int j = 0; j < 8; ++j) { w0[j] = cw[c + j]; w1[j] = cw[MIXW + c + j]; w2[j] = cw[2 * MIXW + c + j]; }
    const u32x4 zero4 = {0u, 0u, 0u, 0u};
    for (int run = blockIdx.x * 4 + sub; run < MR / 16 + 1; run += F.G * 4) {
        int b, pos0; if (run < MR / 16) { b = run >> 8; pos0 = NMETA + (run & 255) * 16; } else { b = 0; pos0 = 0; }
        float S[8], z1[8], z2[8];
#pragma unroll
        for (int j = 0; j < 8; ++j) { S[j] = 0.f; z1[j] = 0.f; z2[j] = 0.f; }
        for (int k = 1; k <= 16; ++k) { if (k <= win && pos0 - k >= 0) { float f[8]; unpack8(*(const u32x4*)(Z + (size_t)prow(b, pos0 - k) * ZP + ZPU + c), f);
#pragma unroll
                for (int j = 0; j < 8; ++j) S[j] += f[j]; } }
        if (pos0 >= 1) { const bf16* zz = Z + (size_t)prow(b, pos0 - 1) * ZP; float a[8], x[8]; unpack8(*(const u32x4*)(zz + ZCC + c), a); unpack8(*(const u32x4*)(zz + ZCX + c), x);
#pragma unroll
            for (int j = 0; j < 8; ++j) z1[j] = a[j] * x[j]; }
        if (pos0 >= 2) { const bf16* zz = Z + (size_t)prow(b, pos0 - 2) * ZP; float a[8], x[8]; unpack8(*(const u32x4*)(zz + ZCC + c), a); unpack8(*(const u32x4*)(zz + ZCX + c), x);
#pragma unroll
            for (int j = 0; j < 8; ++j) z2[j] = a[j] * x[j]; }
        for (int t0 = 0; t0 < 16; t0 += 4) {
            u32x4 cbw[4], ccw[4], cxw[4], puw[4], olw[4];
#pragma unroll
            for (int i = 0; i < 4; ++i) { const int pos = pos0 + t0 + i; const bf16* zr = Z + (size_t)prow(b, pos) * ZP;
                cbw[i] = *(const u32x4*)(zr + ZCB + c); ccw[i] = *(const u32x4*)(zr + ZCC + c); cxw[i] = *(const u32x4*)(zr + ZCX + c); puw[i] = *(const u32x4*)(zr + ZPU + c);
                olw[i] = pos - win >= 0 ? *(const u32x4*)(Z + (size_t)prow(b, pos - win) * ZP + ZPU + c) : zero4; }
#pragma unroll
            for (int i = 0; i < 4; ++i) { const int pos = pos0 + t0 + i; const int row = prow(b, pos);
                float cb[8], cc[8], cx[8], pu[8], ol[8], yb[8], yc[8];
                unpack8(cbw[i], cb); unpack8(ccw[i], cc); unpack8(cxw[i], cx); unpack8(puw[i], pu); unpack8(olw[i], ol);
                const int cnt = pos + 1 < win ? pos + 1 : win; const float inv = 1.0f / (float)cnt;
#pragma unroll
                for (int j = 0; j < 8; ++j) { const float zc = cc[j] * cx[j];
                    yb[j] = cb[j] * (w0[j] * z2[j] + w1[j] * z1[j] + w2[j] * zc); z2[j] = z1[j]; z1[j] = zc;
                    S[j] += pu[j] - ol[j]; yc[j] = S[j] * inv - pu[j]; }
                bf16* yr = YS + (size_t)row * 3072;
                *(u32x4*)(yr + MIXW + c) = pack8(yb); *(u32x4*)(yr + 2 * MIXW + c) = pack8(yc);
            }
        }
    }
}

__device__ __forceinline__ void act_fix_phase(Frame& F, int l) {
    unsigned char* ws = kws(); const float* EA = (const float*)(ws + WS_EA); const float* EU = (const float*)(ws + WS_EU); const float* AUM = (const float*)(ws + WS_AUM); bf16* ACT = (bf16*)(ws + WS_ACT);
    const float* cw = kin(I_FCW) + (size_t)l * 3 * DFF;
    constexpr int NROWS = 64 * 2 + NMETA;
    for (int e = blockIdx.x * NTHREADS + F.tid; e < NROWS * DFF; e += F.G * NTHREADS) {
        const int ri = e / DFF, c = e - ri * DFF; const int cm = (c >> 7) * 256 + (c & 127);
        float a0 = 0.f, a1 = 0.f, a2, uu; int row;
        if (ri < 128) { const int pm = ri >> 1, j = ri & 1; row = pm * 256 + j;
            a2 = EA[((size_t)pm * 4 + 2 + j) * DFF + c]; uu = EU[((size_t)pm * 2 + j) * DFF + c];
            float p255, p254;
            if ((pm & 15) == 0) { p255 = AUM[(size_t)15 * 2 * DFF + cm]; p254 = AUM[(size_t)14 * 2 * DFF + cm]; }
            else { p255 = EA[((size_t)(pm - 1) * 4 + 1) * DFF + c]; p254 = EA[((size_t)(pm - 1) * 4 + 0) * DFF + c]; }
            if (j == 0) { a1 = p255; a0 = p254; } else { a1 = EA[((size_t)pm * 4 + 2) * DFF + c]; a0 = p255; }
        } else { const int p = ri - 128; row = MR + p;
            a2 = AUM[(size_t)p * 2 * DFF + cm]; uu = AUM[(size_t)p * 2 * DFF + cm + 128];
            if (p >= 1) a1 = AUM[(size_t)(p - 1) * 2 * DFF + cm]; if (p >= 2) a0 = AUM[(size_t)(p - 2) * 2 * DFF + cm]; }
        const float cv = cw[c] * a0 + cw[DFF + c] * a1 + cw[2 * DFF + c] * a2;
        ACT[(size_t)row * DFF + c] = (bf16)f2bf(gelu_tanh(cv) * uu);
    }
}

#define WSP(T, off) ((T*)(ws + (off)))
__global__ void __launch_bounds__(NTHREADS, 2) fwd(Args args_unused) {
    extern __shared__ __attribute__((aligned(16))) unsigned char lds_raw[];
    Frame F;
    F.lds = (LAS unsigned char*)lds_raw;
    F.tid = threadIdx.x; F.lane = F.tid & 63; F.wave = __builtin_amdgcn_readfirstlane(F.tid >> 6);
    F.G = gridDim.x; F.gw = blockIdx.x * NWAVES + F.wave; F.ngw = F.G * NWAVES;
    volatile LAS unsigned* MISC = (volatile LAS unsigned*)(F.lds + MISC_OFF);
    for (int u = F.tid; u < (LDS_BYTES - LDSCTL_OFF) / 4; u += NTHREADS) ((LAS unsigned*)(F.lds + LDSCTL_OFF))[u] = 0u;
    __syncthreads();
    int lo, hi; { kptr_t kb = kbase(); lo = *(const int __attribute__((address_space(4)))*)(kb + 152); hi = *(const int __attribute__((address_space(4)))*)(kb + 156); }
    const bool multi = (hi - lo) > 1;
    if (multi) (void)xcd_barrier_post((unsigned*)(kws() + WS_CTL) + CW_BAR, MISC + 8);
#ifndef PH_MASK
#define PH_MASK 0x1fff
#endif
#define IN(k) (lo <= (k) && (k) < hi)
#define PM(k) ((PH_MASK >> (k)) & 1)
#ifndef REP_MASK
#define REP_MASK 0
#endif
#define NREP(k) (((REP_MASK >> (k)) & 1) ? 2 : 1)
#define SEAM(k) do { if (IN(k) && IN((k) + 1)) { XcdBarrier bar_; bar_.bar = (unsigned*)(kws() + WS_CTL) + CW_BAR; bar_.x = xb_xcc_id(); bar_.st = (volatile LAS unsigned*)(F.lds + MISC_OFF) + 8; xcd_barrier(bar_, F.wave == 0 && lane_id() == 0); } } while (0)

    if (PM(0) && IN(0)) { for (int rep = 0; rep < NREP(0); ++rep) weights_phase(F, 0); norm0_phase(F); SEAM(0); }

    for (int l = 0; l < DEPTH; ++l) {
        const int pb = 1 + NPL * l;
#define REFRESH() refresh(F)
        if (PM(1) && IN(pb + 0)) { REFRESH();
            unsigned char* ws = kws();
            const bf16* H = WSP(const bf16, WS_H); const bf16* Bt_in = WSP(const bf16, WS_W + W_IN); bf16* Z = WSP(bf16, WS_Z); float* IFb = WSP(float, WS_IF);
            const unsigned char* H8 = WSP(const unsigned char, WS_H8); const unsigned char* Bt_g8 = (const unsigned char*)(Bt_in + (size_t)ZG * DM);
            {
                pg8::Gemm g{H, Bt_in, DM, DM, DM}; pg8::OrderStd S; S.init(MR, ZG, F.G, (int)blockIdx.x);
                pg8::EpiBf16 E{Z, ZP};
                for (int rep = 0; rep < NREP(1); ++rep)
                pg8::gemm_phase<pg8::EpiBf16, pg8::OrderStd, true>(F.lds, g, S, E, F.wave);
            }
            {
                pg8::Gemm g{(const bf16*)H8, (const bf16*)Bt_g8, DM / 2, DM / 2, DM / 2}; pg8::OrderStd S; S.init(MR, 3 * DM, F.G, (int)blockIdx.x);
                pg8::EpiGate E{WSP(unsigned char, WS_GT), 1.0f / W8_SCALE};
                for (int rep = 0; rep < NREP(5); ++rep)
                pg8::gemm_phase<pg8::EpiGate, pg8::OrderStd, true, true>(F.lds, g, S, E, F.wave);
            }
            LAS f32x4* red = (LAS f32x4*)F.lds;
            constexpr int T_IF = MT / 16, T_MB = ZG / 16, T_MG = 3 * DM / 16;
            thin_wg<4, 2>(F, T_IF + T_MB + T_MG, red,
                [&](int ti, int ks) { if (ti < T_IF) return thin_part(H + (size_t)ti * 16 * DM, DM, Bt_in + (size_t)NIN * DM, DM, ks * (DM / 2), DM / 2, F.lane);
                    ti -= T_IF; if (ti < T_MB) return thin_part(H + (size_t)MR * DM, DM, Bt_in + (size_t)ti * 16 * DM, DM, ks * (DM / 2), DM / 2, F.lane);
                    ti -= T_MB; return thin_part8(H8 + (size_t)MR * DM, DM, Bt_g8 + (size_t)ti * 16 * DM, DM, ks * (DM / 2), DM / 2, F.lane); },
                [&](int ti, f32x4 a) {
                    if (ti < T_IF) {
#pragma unroll
                        for (int i = 0; i < 4; ++i) IFb[(size_t)(ti * 16 + 4 * (F.lane >> 4) + i) * 16 + (F.lane & 15)] = a[i];
                        return; }
                    ti -= T_IF;
                    if (ti < T_MB) { const int col = ti * 16 + (F.lane & 15);
#pragma unroll
                        for (int i = 0; i < 4; ++i) { const int row = MR + 4 * (F.lane >> 4) + i; Z[(size_t)row * ZP + col] = (bf16)f2bf(a[i]); }
                        return; }
                    ti -= T_MB; { const int col = ti * 16 + (F.lane & 15); bf16* GM = WSP(bf16, WS_GM);
#pragma unroll
                        for (int i = 0; i < 4; ++i) GM[(4 * (F.lane >> 4) + i) * (3 * DM) + col] = (bf16)f2bf(sigmoidf_(a[i] * (1.0f / W8_SCALE))); } });
            SEAM(pb + 0);
        }
        if (PM(2) && IN(pb + 1)) { REFRESH(); for (int rep = 0; rep < NREP(2); ++rep) mlstm_u_phase(F, l); for (int rep = 0; rep < NREP(5); ++rep) mix_phase(F, l); SEAM(pb + 1); }
        if (PM(3) && IN(pb + 2)) { REFRESH(); mlstm_scan_phase(F); SEAM(pb + 2); }
        if (PM(4) && IN(pb + 3)) { REFRESH(); for (int rep = 0; rep < NREP(4); ++rep) mlstm_out_phase(F, l); SEAM(pb + 3); }
        if (PM(6) && IN(pb + 5)) { REFRESH();
            unsigned char* ws = kws();
            const bf16* YS = WSP(const bf16, WS_YS); const bf16* Bt_br = WSP(const bf16, WS_W + W_BR); const bf16* GM = WSP(const bf16, WS_GM); bf16* MG = WSP(bf16, WS_MG);
            pg8::Gemm g{YS, Bt_br, 3072, 3072, 3072}; pg8::OrderStd S; S.init(MR, DM, F.G, (int)blockIdx.x);
            pg8::EpiBranch E{WSP(const unsigned char, WS_GT), MG};
            for (int rep = 0; rep < NREP(6); ++rep)
            pg8::gemm_phase<pg8::EpiBranch, pg8::OrderStd, true>(F.lds, g, S, E, F.wave);
            thin_wg<1, 8>(F, DM / 16, (LAS f32x4*)F.lds,
                [&](int ti, int ks) { const int col = ti * 16 + (F.lane & 15); f32x4 tot = {0.f, 0.f, 0.f, 0.f};
#pragma unroll
                    for (int n = 0; n < 3; ++n) { const f32x4 a = thin_part(YS + (size_t)MR * 3072 + n * MIXW, 3072, Bt_br + (size_t)ti * 16 * 3072 + n * MIXW, 3072, ks * (MIXW / 8), MIXW / 8, F.lane);
#pragma unroll
                        for (int i = 0; i < 4; ++i) tot[i] += a[i] * bf2f(GM[(4 * (F.lane >> 4) + i) * (3 * DM) + n * DM + col]); }
                    return tot; },
                [&](int ti, f32x4 a) { const int col = ti * 16 + (F.lane & 15);
#pragma unroll
                    for (int i = 0; i < 4; ++i) MG[(size_t)(MR + 4 * (F.lane >> 4) + i) * DM + col] = (bf16)f2bf(a[i]); });
            SEAM(pb + 5);
        }
        if (PM(7) && IN(pb + 6)) { REFRESH();
            unsigned char* ws = kws();
            const bf16* MG = WSP(const bf16, WS_MG); const bf16* Bt_out = WSP(const bf16, WS_W + W_OUT); bf16* MIX = WSP(bf16, WS_MIX);
            pg8::Gemm g{MG, Bt_out, DM, DM, DM}; pg8::OrderStd S; S.init(MR, DM, F.G, (int)blockIdx.x);
            pg8::EpiBf16 E{MIX, DM};
            for (int rep = 0; rep < NREP(7); ++rep)
            pg8::gemm_phase<pg8::EpiBf16, pg8::OrderStd, true>(F.lds, g, S, E, F.wave);
            thin_wg<1, 8>(F, DM / 16, (LAS f32x4*)F.lds,
                [&](int ti, int ks) { return thin_part(MG + (size_t)MR * DM, DM, Bt_out + (size_t)ti * 16 * DM, DM, ks * (DM / 8), DM / 8, F.lane); },
                [&](int ti, f32x4 a) {
#pragma unroll
                    for (int i = 0; i < 4; ++i) MIX[(size_t)(MR + 4 * (F.lane >> 4) + i) * DM + ti * 16 + (F.lane & 15)] = (bf16)f2bf(a[i]); });
            SEAM(pb + 6);
        }
        if (PM(8) && IN(pb + 7)) { REFRESH();
            unsigned char* ws = kws();
            for (int rep = 0; rep < (l == 0 ? NREP(8) : 1); ++rep)
            nrn_phase(F, WSP(const bf16, WS_MIX), l == 0 ? (const void*)kin(I_X) : (const void*)kout(), l != 0, l == 0 ? kin(I_META) : WSP(const float, WS_XM), WSP(void, WS_XB), true, kin(I_NQM) + (size_t)l * DM, kin(I_NPF) + (size_t)l * DM, false);
            SEAM(pb + 7);
        }
        if (PM(9) && IN(pb + 8)) { REFRESH();
            unsigned char* ws = kws();
            const bf16* H = WSP(const bf16, WS_H); const bf16* Bt_ffi = WSP(const bf16, WS_W + W_FFI); float* AUM = WSP(float, WS_AUM);
            pg8::Gemm g{H, Bt_ffi, DM, DM, DM}; pg8::OrderStd S; S.init(MR, 2 * DFF, F.G, (int)blockIdx.x);
            pg8::EpiAct E{WSP(bf16, WS_ACT), WSP(float, WS_EA), WSP(float, WS_EU), kin(I_FCW) + (size_t)l * 3 * DFF, (LAS float*)(F.lds + XCH_OFF)};
            for (int rep = 0; rep < NREP(9); ++rep)
            pg8::gemm_phase<pg8::EpiAct, pg8::OrderStd, true>(F.lds, g, S, E, F.wave);
            thin_wg<4, 2>(F, 2 * DFF / 16, (LAS f32x4*)F.lds,
                [&](int ti, int ks) { return thin_part(H + (size_t)MR * DM, DM, Bt_ffi + (size_t)ti * 16 * DM, DM, ks * (DM / 2), DM / 2, F.lane); },
                [&](int ti, f32x4 a) {
#pragma unroll
                    for (int i = 0; i < 4; ++i) AUM[(size_t)(4 * (F.lane >> 4) + i) * (2 * DFF) + ti * 16 + (F.lane & 15)] = a[i]; });
            SEAM(pb + 8);
        }
        if (PM(10) && IN(pb + 9)) { REFRESH(); act_fix_phase(F, l); SEAM(pb + 9); }
        if (PM(11) && IN(pb + 10)) { REFRESH();
            unsigned char* ws = kws();
            const bf16* ACT = WSP(const bf16, WS_ACT); const bf16* Bt_ffo = WSP(const bf16, WS_W + W_FFO); bf16* MIX = WSP(bf16, WS_MIX);
            pg8::Gemm g{ACT, Bt_ffo, DFF, DFF, DFF}; pg8::OrderStd S; S.init(MR, DM, F.G, (int)blockIdx.x);
            pg8::EpiBf16 E{MIX, DM};
            for (int rep = 0; rep < NREP(11); ++rep)
            pg8::gemm_phase<pg8::EpiBf16, pg8::OrderStd, true>(F.lds, g, S, E, F.wave);
            thin_wg<1, 8>(F, DM / 16, (LAS f32x4*)F.lds,
                [&](int ti, int ks) { return thin_part(ACT + (size_t)MR * DFF, DFF, Bt_ffo + (size_t)ti * 16 * DFF, DFF, ks * (DFF / 8), DFF / 8, F.lane); },
                [&](int ti, f32x4 a) {
#pragma unroll
                    for (int i = 0; i < 4; ++i) MIX[(size_t)(MR + 4 * (F.lane >> 4) + i) * DM + ti * 16 + (F.lane & 15)] = (bf16)f2bf(a[i]); });
            SEAM(pb + 10);
        }
        if (PM(12) && IN(pb + 11)) { REFRESH();
            unsigned char* ws = kws();
            nrn_phase(F, WSP(const bf16, WS_MIX), WSP(const void, WS_XB), true, WSP(const float, WS_XM), (void*)kout(), l + 1 < DEPTH, kin(I_NQF) + (size_t)l * DM, l + 1 < DEPTH ? kin(I_NPM) + (size_t)(l + 1) * DM : nullptr, true);
            if (l + 1 < DEPTH) weights_phase(F, l + 1);
            SEAM(pb + 11);
        }
    }
#undef IN
#undef SEAM
}

#ifndef N_LAUNCH_SPLIT
#define N_LAUNCH_SPLIT 0
#endif
extern "C" void kernel_launch(void* const* d_in, const int* in_sizes, int n_in, void* d_out, int out_size, void* d_ws, size_t ws_size, hipStream_t stream) {
    static int grid = 0;
    if (grid == 0) {
        if (n_in != 17 || out_size != MR * DM || ws_size < WS_END) { fprintf(stderr, "kernel_launch: unexpected sizes n_in %d out %d ws %zu (need %zu)\n", n_in, out_size, ws_size, (size_t)WS_END); grid = -1; return; }
        int dev = 0, cus = 0, per_cu = 0;
        if (hipGetDevice(&dev) != hipSuccess || hipDeviceGetAttribute(&cus, hipDeviceAttributeMultiprocessorCount, dev) != hipSuccess) { grid = -1; return; }
        if (hipFuncSetAttribute((const void*)fwd, hipFuncAttributeMaxDynamicSharedMemorySize, LDS_BYTES) != hipSuccess) { fprintf(stderr, "kernel_launch: hipFuncSetAttribute failed\n"); grid = -1; return; }
        if (hipOccupancyMaxActiveBlocksPerMultiprocessor(&per_cu, (const void*)fwd, NTHREADS, LDS_BYTES) != hipSuccess || per_cu < 1) { fprintf(stderr, "kernel_launch: occupancy query says %d\n", per_cu); }
        (void)hipGetLastError();
        grid = cus;
    }
    if (grid < 0) return;
    (void)hipMemsetAsync((char*)d_ws + WS_CTL, 0, CTL_ZERO_BYTES, stream);
    Args a{};
    for (int i = 0; i < 17; ++i) a.in[i] = (const float*)d_in[i];
    a.out = (float*)d_out; a.ws = (unsigned char*)d_ws;
#if N_LAUNCH_SPLIT
    for (int p = 0; p < N_PHASES; ++p) { a.ph_lo = p; a.ph_hi = p + 1; hipLaunchKernelGGL(fwd, dim3(grid), dim3(NTHREADS), LDS_BYTES, stream, a); }
#else
    a.ph_lo = 0; a.ph_hi = N_PHASES; hipLaunchKernelGGL(fwd, dim3(grid), dim3(NTHREADS), LDS_BYTES, stream, a);
#endif
}
```

```cpp
#include <hip/hip_runtime.h>
#include <cstdio>
#include <cstdint>

#define LAS __attribute__((address_space(3)))
#define GAS __attribute__((address_space(1)))
typedef unsigned short bf16;
typedef short bf16x8 __attribute__((ext_vector_type(8)));
typedef float f32x4 __attribute__((ext_vector_type(4)));
typedef float f32x2 __attribute__((ext_vector_type(2)));
typedef unsigned u32x4 __attribute__((ext_vector_type(4)));
typedef unsigned u32x2 __attribute__((ext_vector_type(2)));
typedef GAS unsigned gu32;

constexpr int DM = 2048, NB = 4, SEQ = 4096, NMETA = 16, MIXW = 1024, NHEAD = 8, DHEAD = 128, DFF = 5632, DEPTH = 2;
constexpr int MR = NB * SEQ;
constexpr int MT = MR + NMETA;
constexpr int NIN = 14336;
constexpr int INCOLS = 14352;
constexpr int ZP = 8256;
constexpr int NIN_ROWS = 14400;
constexpr float RMS_EPS = 1e-6f;
constexpr int ZQ = 0, ZK = 1024, ZV = 2048, ZO = 3072, ZCB = 4096, ZCC = 5120, ZCX = 6144, ZPU = 7168, ZG = 8192;

constexpr size_t MiB = 1u << 20;
constexpr size_t WS_CTL = 0, CTL_ZERO_BYTES = 64 * 1024;
constexpr size_t WS_IF = 1 * MiB;
constexpr size_t WS_XM = 3 * MiB;
constexpr size_t WS_GM = 3 * MiB + 256 * 1024;
constexpr size_t WS_W = 4 * MiB;
constexpr size_t W_IN = 0, W_BR = W_IN + (size_t)NIN_ROWS * DM * 2, W_OUT = W_BR + (size_t)DM * 3072 * 2, W_FFI = W_OUT + (size_t)DM * DM * 2,
                 W_FFO = W_FFI + (size_t)2 * DFF * DM * 2, W_END = W_FFO + (size_t)DM * DFF * 2;
static_assert(W_END <= 143 * MiB, "weights");
constexpr size_t WS_Z = 147 * MiB;
constexpr size_t WS_GT = 406 * MiB;
constexpr size_t WS_ACT = WS_Z;
constexpr size_t WS_EA = WS_Z + 180 * MiB;
constexpr size_t WS_EU = WS_Z + 188 * MiB;
constexpr size_t WS_AUM = WS_Z + 192 * MiB;
constexpr size_t WS_YS = 598 * MiB;
constexpr size_t WS_H = WS_YS;
constexpr size_t WS_H8 = WS_YS + (size_t)MT * DM * 2;

constexpr size_t WS_MG = 695 * MiB;
constexpr size_t WS_XB = WS_MG;
constexpr size_t WS_MIX = 760 * MiB;
constexpr size_t WS_END = 840 * MiB;
static_assert(WS_H + (size_t)MT * DM * 2 <= WS_H8 && WS_H8 + (size_t)MT * DM <= WS_MG, "H8");
static_assert(WS_Z + (size_t)MT * ZP * 2 <= WS_GT && WS_GT + (size_t)64 * 24 * 65536 <= WS_YS && WS_ACT + (size_t)MT * DFF * 2 <= WS_EA && WS_EA + (size_t)64 * 4 * DFF * 4 <= WS_EU && WS_EU + (size_t)64 * 2 * DFF * 4 <= WS_AUM && WS_AUM + (size_t)16 * 2 * DFF * 4 <= WS_YS, "map1");
static_assert(WS_YS + (size_t)MT * 3072 * 2 <= WS_MG && WS_MG + (size_t)MT * DM * 2 <= WS_MIX && WS_MIX + (size_t)80 * MiB <= WS_END && (size_t)MT * DM * 2 <= 80 * MiB, "map2");
constexpr int CW_BAR = 4096;

__device__ __forceinline__ unsigned f2bf(float f) { unsigned u = __builtin_bit_cast(unsigned, f); return (u + 0x7fffu + ((u >> 16) & 1u)) >> 16; }
__device__ __forceinline__ unsigned pk2(float lo, float hi) { return f2bf(lo) | (f2bf(hi) << 16); }
__device__ __forceinline__ float bf2f(bf16 b) { return __builtin_bit_cast(float, (unsigned)b << 16); }
__device__ __forceinline__ float bflo(unsigned w) { return __builtin_bit_cast(float, w << 16); }
__device__ __forceinline__ float bfhi(unsigned w) { return __builtin_bit_cast(float, w & 0xffff0000u); }
__device__ __forceinline__ float sigmoidf_(float x) { return __builtin_amdgcn_rcpf(1.0f + __builtin_amdgcn_exp2f(-1.4426950408889634f * x)); }
__device__ __forceinline__ float wave_sum(float v) {
#pragma unroll
    for (int o = 1; o < 64; o <<= 1) v += __shfl_xor(v, o);
    return v;
}
__device__ __forceinline__ float gelu_tanh(float x) {
    const float p = x * __builtin_fmaf(0.1029432396f * x, x, 2.3022081981f);
    return x * __builtin_amdgcn_rcpf(1.0f + __builtin_amdgcn_exp2f(-p));
}
__device__ __forceinline__ int prow(int b, int pos) { return pos < NMETA ? MR + pos : b * SEQ + pos - NMETA; }
__device__ __forceinline__ int lane_id() { int l; asm volatile("v_mbcnt_lo_u32_b32 %0, -1, 0\n\tv_mbcnt_hi_u32_b32 %0, -1, %0" : "=v"(l)); return l; }
#define LDS_WAIT() asm volatile("s_waitcnt lgkmcnt(0)" ::: "memory")
#define VM_WAIT() asm volatile("s_waitcnt vmcnt(0)" ::: "memory")

namespace pg8 {
constexpr int BM = 256, BK = 64, HALF = 128, HTB = HALF * BK * 2, STAGE_BYTES = 8 * HTB, NXCD = 8, WGM = 8;
__host__ __device__ __forceinline__ int lds_byte(int r, int c) { const int st = (r >> 4) * 2 + (c >> 5), rr = r & 15, cc = c & 31, ob = rr * 64 + cc * 2; return st * 1024 + (ob ^ (((ob >> 9) & 1) << 5)); }
__host__ __device__ __forceinline__ void stage_rc(int b, int& R, int& C) { const int st = b / 1024, sb = b % 1024, swz = sb ^ (((sb >> 9) & 1) << 5); R = (st >> 1) * 16 + swz / 64; C = (st & 1) * 32 + (swz % 64) / 2; }
__host__ __device__ __forceinline__ int perm32(int rho) { const int n = rho >> 4, i = rho & 15; return 8 * (i >> 2) + 4 * n + (i & 3); }

typedef int v8i32 __attribute__((ext_vector_type(8)));
typedef int v4i32 __attribute__((ext_vector_type(4)));
__device__ __forceinline__ v8i32 cat8(const bf16x8 a, const bf16x8 b) { const v4i32 x = __builtin_bit_cast(v4i32, a), y = __builtin_bit_cast(v4i32, b); return __builtin_shufflevector(x, y, 0, 1, 2, 3, 4, 5, 6, 7); }
struct Unit { int pm, pn; };
struct Gemm { const bf16* A; const bf16* Bt; int lda, ldb, K; };

__device__ __forceinline__ void tile_of(int wgid, int nM, int nN, int& pm, int& pn) {
    const int nwg = nM * nN;
    { const int q = nwg / NXCD, r = nwg % NXCD, xcd = wgid % NXCD, off = wgid / NXCD; wgid = (xcd < r ? xcd * (q + 1) : r * (q + 1) + (xcd - r) * q) + off; }
    const int nig = WGM * nN, gid = wgid / nig, fm = gid * WGM, gsz = (nM - fm) < WGM ? (nM - fm) : WGM;
    pm = fm + ((wgid % nig) % gsz); pn = (wgid % nig) / gsz;
}
struct OrderStd {
    int nM, nN, nwg, G, c;
    __device__ void init(int M, int N, int G_, int c_) { nM = M / BM; nN = N / BM; nwg = nM * nN; G = G_; c = c_; }
    __device__ bool next(int i, Unit& u) const {
        const long L = (long)i * G + c; if (L >= nwg) return false;
        tile_of((int)L, nM, nN, u.pm, u.pn); return true;
    }
};
__device__ __forceinline__ unsigned cvt_pk_bf16(float lo, float hi) { unsigned r; asm volatile("v_cvt_pk_bf16_f32 %0, %1, %2" : "=v"(r) : "v"(lo), "v"(hi)); return r; }

struct EpiF32 {
    static constexpr bool PERM = false, HAS_MID = false;
    float* C; int ldc;
    __device__ __forceinline__ void operator()(const f32x4 (&acc)[2][2][4][2], const Unit& u, int wr, int wc, int fr, int fq) const {
        const int row0 = u.pm * BM + wr * 64 + fr, col0 = u.pn * BM + wc * 32 + 4 * fq;
#pragma unroll
        for (int ai = 0; ai < 2; ++ai)
#pragma unroll
            for (int m = 0; m < 4; ++m) { float* rowp = C + (size_t)(row0 + ai * HALF + m * 16) * ldc + col0;
#pragma unroll
                for (int bj = 0; bj < 2; ++bj)
#pragma unroll
                    for (int n = 0; n < 2; ++n) *(f32x4*)(rowp + bj * HALF + n * 16) = acc[ai][bj][m][n]; }
    }
};
struct EpiBf16 {
    static constexpr bool PERM = true, HAS_MID = false;
    bf16* O; int ldc; int gate_pn; float gscale;
    __device__ __forceinline__ void operator()(const f32x4 (&acc)[2][2][4][2], const Unit& u, int wr, int wc, int fr, int fq) const {
        const int row0 = u.pm * BM + wr * 64 + fr, col0 = u.pn * BM + wc * 32 + 8 * fq;
        const bool gate = u.pn >= gate_pn;
#pragma unroll
        for (int ai = 0; ai < 2; ++ai)
#pragma unroll
            for (int m = 0; m < 4; ++m) { bf16* rowp = O + (size_t)(row0 + ai * HALF + m * 16) * ldc + col0;
#pragma unroll
                for (int bj = 0; bj < 2; ++bj) { f32x4 v0 = acc[ai][bj][m][0], v1 = acc[ai][bj][m][1];
                    if (gate) {
#pragma unroll
                        for (int j = 0; j < 4; ++j) { v0[j] = sigmoidf_(v0[j] * gscale); v1[j] = sigmoidf_(v1[j] * gscale); } }
                    u32x4 w; w.x = cvt_pk_bf16(v0[0], v0[1]); w.y = cvt_pk_bf16(v0[2], v0[3]); w.z = cvt_pk_bf16(v1[0], v1[1]); w.w = cvt_pk_bf16(v1[2], v1[3]);
                    *(u32x4*)(rowp + bj * HALF) = w; } }
    }
};
constexpr int GT_COLS = 24;
__device__ __forceinline__ float ub0(unsigned x) { return (float)(x & 0xffu); }
__device__ __forceinline__ float ub1(unsigned x) { return (float)((x >> 8) & 0xffu); }
__device__ __forceinline__ float ub2(unsigned x) { return (float)((x >> 16) & 0xffu); }
__device__ __forceinline__ float ub3(unsigned x) { return (float)(x >> 24); }
struct EpiGate {
    static constexpr bool PERM = true, HAS_MID = false;
    unsigned char* G; float gscale;
    static __device__ __forceinline__ unsigned q4(const f32x4 v, float gs) { unsigned p = 0;
        p = __builtin_amdgcn_cvt_pk_u8_f32(__builtin_rintf(255.0f * sigmoidf_(v[0] * gs)), 0, p); p = __builtin_amdgcn_cvt_pk_u8_f32(__builtin_rintf(255.0f * sigmoidf_(v[1] * gs)), 1, p);
        p = __builtin_amdgcn_cvt_pk_u8_f32(__builtin_rintf(255.0f * sigmoidf_(v[2] * gs)), 2, p); p = __builtin_amdgcn_cvt_pk_u8_f32(__builtin_rintf(255.0f * sigmoidf_(v[3] * gs)), 3, p); return p; }
    __device__ __forceinline__ void operator()(const f32x4 (&acc)[2][2][4][2], const Unit& u, int wr, int wc, int fr, int fq) const {
        unsigned char* base = G + ((size_t)(u.pm * GT_COLS + u.pn) << 16) + ((((wr * 4 + wc) * 64) + fq * 16 + fr) << 4);
#pragma unroll
        for (int ai = 0; ai < 2; ++ai)
#pragma unroll
            for (int m = 0; m < 4; ++m) { u32x4 w;
                w.x = q4(acc[ai][0][m][0], gscale); w.y = q4(acc[ai][0][m][1], gscale); w.z = q4(acc[ai][1][m][0], gscale); w.w = q4(acc[ai][1][m][1], gscale);
                *(u32x4*)(base + ((ai * 4 + m) << 13)) = w; }
    }
};
struct EpiBranch {
    static constexpr bool PERM = true, HAS_MID = true;
    const unsigned char* Gt;
    bf16* MG;
    static __device__ __forceinline__ float fl(float g) { return fmaxf(g, 1e-30f); }
    static __device__ __forceinline__ void rs4(f32x4& v, unsigned a, unsigned b) {
        v[0] *= fl(ub0(a)) * __builtin_amdgcn_rcpf(fl(ub0(b))); v[1] *= fl(ub1(a)) * __builtin_amdgcn_rcpf(fl(ub1(b)));
        v[2] *= fl(ub2(a)) * __builtin_amdgcn_rcpf(fl(ub2(b))); v[3] *= fl(ub3(a)) * __builtin_amdgcn_rcpf(fl(ub3(b))); }
    __device__ __forceinline__ void mid(f32x4 (&acc)[2][2][4][2], const Unit& u, int sidx, int wr, int wc, int fr, int fq) const {
        asm volatile("" : "+v"(fr), "+v"(fq));
        const unsigned char* gp = Gt + ((size_t)(u.pm * GT_COLS + (sidx - 1) * 8 + u.pn) << 16) + ((((wr * 4 + wc) * 64) + fq * 16 + fr) << 4);
#pragma unroll
        for (int ai = 0; ai < 2; ++ai) {
#pragma unroll
            for (int m = 0; m < 4; ++m) { const int so = (ai * 4 + m) << 13;
                const u32x4 ga = *(const u32x4*)(gp + so), gb = *(const u32x4*)(gp + ((size_t)8 << 16) + so);
                rs4(acc[ai][0][m][0], ga.x, gb.x); rs4(acc[ai][0][m][1], ga.y, gb.y); rs4(acc[ai][1][m][0], ga.z, gb.z); rs4(acc[ai][1][m][1], ga.w, gb.w); }
            asm volatile("" ::: "memory"); }
        asm volatile("s_waitcnt vmcnt(0)" ::: "memory");
    }
    static __device__ __forceinline__ unsigned fin4(const f32x4 v, unsigned g, bool hi) {
        const float s = 1.0f / 255.0f;
        return hi ? cvt_pk_bf16(v[2] * (fl(ub2(g)) * s), v[3] * (fl(ub3(g)) * s)) : cvt_pk_bf16(v[0] * (fl(ub0(g)) * s), v[1] * (fl(ub1(g)) * s)); }
    __device__ __forceinline__ void operator()(const f32x4 (&acc)[2][2][4][2], const Unit& u, int wr, int wc, int fr, int fq) const {
        asm volatile("" : "+v"(fr), "+v"(fq));
        const int row0 = u.pm * BM + wr * 64 + fr, col0 = u.pn * BM + wc * 32 + 8 * fq;
        const unsigned char* gp = Gt + ((size_t)(u.pm * GT_COLS + 16 + u.pn) << 16) + ((((wr * 4 + wc) * 64) + fq * 16 + fr) << 4);
#pragma unroll
        for (int ai = 0; ai < 2; ++ai)
#pragma unroll
            for (int m = 0; m < 4; ++m) { const size_t r = (size_t)(row0 + ai * HALF + m * 16);
                const u32x4 g = *(const u32x4*)(gp + ((ai * 4 + m) << 13));
                u32x4 w0, w1;
                w0.x = fin4(acc[ai][0][m][0], g.x, false); w0.y = fin4(acc[ai][0][m][0], g.x, true); w0.z = fin4(acc[ai][0][m][1], g.y, false); w0.w = fin4(acc[ai][0][m][1], g.y, true);
                w1.x = fin4(acc[ai][1][m][0], g.z, false); w1.y = fin4(acc[ai][1][m][0], g.z, true); w1.z = fin4(acc[ai][1][m][1], g.w, false); w1.w = fin4(acc[ai][1][m][1], g.w, true);
                *(u32x4*)(MG + r * DM + col0) = w0; *(u32x4*)(MG + r * DM + col0 + HALF) = w1; }
    }
};

#define DPPZ(srcv, CTRL) __builtin_bit_cast(float, __builtin_amdgcn_mov_dpp(__builtin_bit_cast(int, (float)(srcv)), (CTRL), 0xf, 0xf, true))
#define DPPF(oldv, srcv, CTRL) __builtin_bit_cast(float, __builtin_amdgcn_mov_dpp(__builtin_bit_cast(int, (float)(srcv)), (CTRL), 0xf, 0xf, false))
#define DPPO(oldv, srcv, CTRL) __builtin_bit_cast(float, __builtin_amdgcn_update_dpp(__builtin_bit_cast(int, (float)(oldv)), __builtin_bit_cast(int, (float)(srcv)), (CTRL), 0xf, 0xf, false))
struct EpiAct {
    static constexpr bool PERM = true, HAS_MID = false;
    bf16* ACT; float* EA; float* EU; const float* cw; LAS float* X;
    __device__ __forceinline__ void operator()(const f32x4 (&acc)[2][2][4][2], const Unit& u, int wr, int wc, int fr, int fq) const {
        asm volatile("" : "+v"(fr), "+v"(fq));
        const int cl = wc * 32 + 8 * fq;
        const int cbase = u.pn * 128 + cl;
        float w0[8], w1[8], w2[8];
        { const f32x4 t0 = *(const f32x4*)(cw + cbase), t1 = *(const f32x4*)(cw + cbase + 4), t2 = *(const f32x4*)(cw + DFF + cbase), t3 = *(const f32x4*)(cw + DFF + cbase + 4),
                      t4 = *(const f32x4*)(cw + 2 * DFF + cbase), t5 = *(const f32x4*)(cw + 2 * DFF + cbase + 4);
#pragma unroll
          for (int j = 0; j < 4; ++j) { w0[j] = t0[j]; w0[4 + j] = t1[j]; w1[j] = t2[j]; w1[4 + j] = t3[j]; w2[j] = t4[j]; w2[4 + j] = t5[j]; } }
        if (fr >= 14) {
#pragma unroll
            for (int ai = 0; ai < 2; ++ai) { LAS float* xp = X + ((ai * 2 + wr) * 2 + (fr - 14)) * 128 + cl; *(LAS f32x4*)xp = acc[ai][0][3][0]; *(LAS f32x4*)(xp + 4) = acc[ai][0][3][1]; }
            if (wr == 1) { float* ep = EA + ((size_t)u.pm * 4 + (fr - 14)) * DFF + cbase; *(f32x4*)ep = acc[1][0][3][0]; *(f32x4*)(ep + 4) = acc[1][0][3][1]; }
        }
        if (fr < 2 && wr == 0) {
            float* ep = EA + ((size_t)u.pm * 4 + 2 + fr) * DFF + cbase; *(f32x4*)ep = acc[0][0][0][0]; *(f32x4*)(ep + 4) = acc[0][0][0][1];
            float* up = EU + ((size_t)u.pm * 2 + fr) * DFF + cbase; *(f32x4*)up = acc[0][1][0][0]; *(f32x4*)(up + 4) = acc[0][1][0][1];
        }
        asm volatile("s_waitcnt lgkmcnt(0)" ::: "memory"); __builtin_amdgcn_s_barrier(); asm volatile("" ::: "memory");
#pragma unroll
        for (int ai = 0; ai < 2; ++ai) {
            f32x4 pa = {0.f, 0.f, 0.f, 0.f}, pb = {0.f, 0.f, 0.f, 0.f};
            if (fr >= 14 && (wr == 1 || ai == 1)) { const int sai = wr == 1 ? ai : ai - 1, swr = wr == 1 ? 0 : 1;
                const LAS float* xp = X + ((sai * 2 + swr) * 2 + (fr - 14)) * 128 + cl; pa = *(const LAS f32x4*)xp; pb = *(const LAS f32x4*)(xp + 4); }
#pragma unroll
            for (int m = 0; m < 4; ++m) {
                float o[8];
#pragma unroll
                for (int j = 0; j < 8; j += 2) {
                    f32x2 cur, uu, x1, x2;
#pragma unroll
                    for (int e = 0; e < 2; ++e) { const int jj = j + e;
                        const float c = jj < 4 ? acc[ai][0][m][0][jj & 3] : acc[ai][0][m][1][jj & 3];
                        const float prv = m == 0 ? (jj < 4 ? pa[jj & 3] : pb[jj & 3]) : (jj < 4 ? acc[ai][0][m - 1][0][jj & 3] : acc[ai][0][m - 1][1][jj & 3]);
                        const float r1 = DPPF(0.f, prv, 0x121), r2 = DPPF(0.f, prv, 0x122);
                        cur[e] = c; uu[e] = jj < 4 ? acc[ai][1][m][0][jj & 3] : acc[ai][1][m][1][jj & 3];
                        x1[e] = DPPO(r1, c, 0x111); x2[e] = DPPO(r2, c, 0x112); }
                    const f32x2 W0 = {w0[j], w0[j + 1]}, W1 = {w1[j], w1[j + 1]}, W2 = {w2[j], w2[j + 1]};
                    const f32x2 cv = __builtin_elementwise_fma(W1, x1, __builtin_elementwise_fma(W0, x2, W2 * cur));
                    const f32x2 pp = __builtin_elementwise_fma(cv * cv, (f32x2){0.1029432396f, 0.1029432396f}, (f32x2){2.3022081981f, 2.3022081981f});
                    const f32x2 ee = -cv * pp;
                    f32x2 dd = {__builtin_amdgcn_exp2f(ee[0]), __builtin_amdgcn_exp2f(ee[1])}; dd = dd + (f32x2){1.0f, 1.0f};
                    const f32x2 rr = {__builtin_amdgcn_rcpf(dd[0]), __builtin_amdgcn_rcpf(dd[1])};
                    const f32x2 oo = (cv * rr) * uu;
                    o[j] = oo[0]; o[j + 1] = oo[1];
                }
                u32x4 w; w.x = cvt_pk_bf16(o[0], o[1]); w.y = cvt_pk_bf16(o[2], o[3]); w.z = cvt_pk_bf16(o[4], o[5]); w.w = cvt_pk_bf16(o[6], o[7]);
                *(u32x4*)(ACT + (size_t)(u.pm * BM + ai * HALF + wr * 64 + m * 16 + fr) * DFF + cbase) = w;
            }
        }
    }
};

template <class Epi, class Sched, bool ALIGN_EPI, bool F8 = false>
__device__ __forceinline__ void gemm_phase(LAS unsigned char* lds, const Gemm g, const Sched& S, const Epi& E, const int wave_id) {
    int tid_ = wave_id * 64 + lane_id(); asm volatile("" : "+v"(tid_));
    const int tid = tid_, wid = __builtin_amdgcn_readfirstlane(tid >> 6), lane = tid & 63, wr = wid >> 2, wc = wid & 3, fr = lane & 15, fq = lane >> 4;
    const int K = g.K, nt = K / BK;
    unsigned voffA[2], voffB[2];
#pragma unroll
    for (int i = 0; i < 2; ++i) { int R, C; stage_rc(tid * 16 + i * 8192, R, C); const int Rb = Epi::PERM ? ((R & ~31) + perm32(R & 31)) : R;
        voffA[i] = (unsigned)(R * g.lda + C) * 2u; voffB[i] = (unsigned)(Rb * g.ldb + C) * 2u; }
    const unsigned kstep = (unsigned)(BK * 2);
    const unsigned hstepA = (unsigned)HALF * g.lda * 2u, hstepB = (unsigned)HALF * g.ldb * 2u;
    const auto rsA = __builtin_amdgcn_make_buffer_rsrc((void*)g.A, 0, 0x7fffffff, 0x00020000);
    const auto rsB = __builtin_amdgcn_make_buffer_rsrc((void*)g.Bt, 0, 0x7fffffff, 0x00020000);
    const unsigned ldsw = (unsigned)wid * 1024u;
    const int aoff = lds_byte(wr * 64 + fr, fq * 8), boff = lds_byte(wc * 32 + fr, fq * 8);
#define PG8_SA(b, h) (((b) * 2 + (h)) * HTB)
#define PG8_SB(b, h) ((4 + (b) * 2 + (h)) * HTB)
#define PG8_STAGE_A(bufoff, soff, voff) do { _Pragma("unroll") for (int _i = 0; _i < 2; ++_i) \
        __builtin_amdgcn_raw_ptr_buffer_load_lds(rsA, (LAS unsigned*)(lds + (bufoff) + ldsw + _i * 8192), 16, (voff)[_i], (int)(soff), 0, 0); } while (0)
#define PG8_STAGE_B(bufoff, soff, voff) do { _Pragma("unroll") for (int _i = 0; _i < 2; ++_i) \
        __builtin_amdgcn_raw_ptr_buffer_load_lds(rsB, (LAS unsigned*)(lds + (bufoff) + ldsw + _i * 8192), 16, (voff)[_i], (int)(soff), 0, 0); } while (0)
#define PG8_LDA(dst, b, h) do { if constexpr (F8) { _Pragma("unroll") for (int m = 0; m < 2; ++m) dst##8[m] = cat8(*(const LAS bf16x8*)(lds + PG8_SA(b, h) + aoff + m * 2048), *(const LAS bf16x8*)(lds + PG8_SA(b, h) + aoff + m * 2048 + 1024)); } \
        else { _Pragma("unroll") for (int m = 0; m < 4; ++m) _Pragma("unroll") for (int k = 0; k < 2; ++k) dst[m][k] = *(const LAS bf16x8*)(lds + PG8_SA(b, h) + aoff + m * 2048 + k * 1024); } } while (0)
#define PG8_LDA_HI(dst, b, h) do { _Pragma("unroll") for (int m = 0; m < 2; ++m) dst##8[m] = cat8(*(const LAS bf16x8*)(lds + PG8_SA(b, h) + aoff + (m + 2) * 2048), *(const LAS bf16x8*)(lds + PG8_SA(b, h) + aoff + (m + 2) * 2048 + 1024)); } while (0)
#define PG8_LDB(dst, b, h) do { _Pragma("unroll") for (int n = 0; n < 2; ++n) { if constexpr (F8) dst##8[n] = cat8(*(const LAS bf16x8*)(lds + PG8_SB(b, h) + boff + n * 2048), *(const LAS bf16x8*)(lds + PG8_SB(b, h) + boff + n * 2048 + 1024)); \
        else { _Pragma("unroll") for (int k = 0; k < 2; ++k) dst[n][k] = *(const LAS bf16x8*)(lds + PG8_SB(b, h) + boff + n * 2048 + k * 1024); } } } while (0)
#define PG8_MMA(ai, bj, At, Bt) do { __builtin_amdgcn_s_setprio(1); _Pragma("unroll") for (int m = 0; m < 4; ++m) _Pragma("unroll") for (int n = 0; n < 2; ++n) _Pragma("unroll") for (int k = 0; k < 2; ++k) \
        acc[ai][bj][m][n] = __builtin_amdgcn_mfma_f32_16x16x32_bf16(Bt[n][k], At[m][k], acc[ai][bj][m][n], 0, 0, 0); __builtin_amdgcn_s_setprio(0); } while (0)
#define PG8_MMA8H(ai, mb) do { __builtin_amdgcn_s_setprio(1); _Pragma("unroll") for (int m = 0; m < 2; ++m) _Pragma("unroll") for (int n = 0; n < 2; ++n) { \
        acc[ai][0][mb + m][n] = __builtin_amdgcn_mfma_scale_f32_16x16x128_f8f6f4(B08[n], At8[m], acc[ai][0][mb + m][n], 0, 0, 0, sc8, 0, sc8); \
        acc[ai][1][mb + m][n] = __builtin_amdgcn_mfma_scale_f32_16x16x128_f8f6f4(B18[n], At8[m], acc[ai][1][mb + m][n], 0, 0, 0, sc8, 0, sc8); } __builtin_amdgcn_s_setprio(0); } while (0)
#define PG8_MMAB(ai, b, h) do { if constexpr (F8) { PG8_MMA8H(ai, 0); PG8_LDA_HI(At, b, h); PG8_MMA8H(ai, 2); } else { PG8_MMA(ai, 0, At, B0); PG8_MMA(ai, 1, At, B1); } } while (0)
#define PG8_WAIT_V(n) asm volatile("s_waitcnt vmcnt(" #n ")" ::: "memory")
#define PG8_WAIT_L(n) asm volatile("s_waitcnt lgkmcnt(" #n ")" ::: "memory")
#define PG8_BAR __builtin_amdgcn_s_barrier()
#define PG8_SCHED __builtin_amdgcn_sched_barrier(0)
#define PG8_UA(u) (((unsigned)(u).pm * BM * g.lda) * 2u)
#define PG8_UB(u) (((unsigned)(u).pn * BM * g.ldb) * 2u)
    Unit cur, nxt; int ui = 0;
    if (!S.next(0, cur)) return;
    f32x4 acc[2][2][4][2];
#pragma unroll
    for (int a = 0; a < 2; ++a)
#pragma unroll
        for (int b = 0; b < 2; ++b)
#pragma unroll
            for (int m = 0; m < 4; ++m)
#pragma unroll
                for (int n = 0; n < 2; ++n) acc[a][b][m][n] = (f32x4){0.f, 0.f, 0.f, 0.f};
    int sc8 = 0x7f7f7f7f; if constexpr (F8) asm volatile("" : "+s"(sc8));
    bf16x8 At[4][2], B0[2][2], B1[2][2]; v8i32 At8[2], B08[2], B18[2];
    unsigned cA = PG8_UA(cur), cB = PG8_UB(cur);
    PG8_STAGE_B(PG8_SB(0, 0), cB, voffB); PG8_STAGE_B(PG8_SB(0, 1), cB + hstepB, voffB); PG8_STAGE_A(PG8_SA(0, 0), cA, voffA); PG8_STAGE_A(PG8_SA(0, 1), cA + hstepA, voffA);
    if (wr == 1) PG8_BAR;
    PG8_WAIT_V(2); PG8_BAR;
    PG8_STAGE_B(PG8_SB(1, 0), cB + kstep, voffB); PG8_STAGE_A(PG8_SA(1, 0), cA + kstep, voffA); PG8_STAGE_B(PG8_SB(1, 1), cB + hstepB + kstep, voffB);
    PG8_WAIT_V(6); PG8_BAR;
    for (;;) {
        const bool has_next = S.next(ui + 1, nxt);
        const unsigned nA = has_next ? PG8_UA(nxt) : cA, nB = has_next ? PG8_UB(nxt) : cB;
        for (int t = 0; t < nt; t += 2) {
            const bool last = (t == nt - 2);
            const unsigned a1 = cA + (unsigned)(t + 1) * kstep;
            const unsigned a2 = last ? nA : cA + (unsigned)(t + 2) * kstep, b2 = last ? nB : cB + (unsigned)(t + 2) * kstep;
            const unsigned a3 = a2 + kstep, b3 = b2 + kstep;
            if constexpr (Epi::HAS_MID) { if (t == 16 || t == 32) { if (wr == 0) PG8_BAR; { const int l2 = lane_id(); E.mid(acc, cur, t >> 4, wr, wc, l2 & 15, l2 >> 4); } if (wr == 1) PG8_BAR; } }
            PG8_LDB(B0, 0, 0); PG8_LDB(B1, 0, 1); PG8_SCHED; PG8_LDA(At, 0, 0); PG8_STAGE_A(PG8_SA(1, 1), a1 + hstepA, voffA);
            PG8_WAIT_V(8); PG8_WAIT_L(0); PG8_BAR; PG8_MMAB(0, 0, 0); PG8_BAR; PG8_SCHED;
            PG8_LDA(At, 0, 1); PG8_STAGE_B(PG8_SB(0, 0), b2, voffB); PG8_STAGE_B(PG8_SB(0, 1), b2 + hstepB, voffB); PG8_STAGE_A(PG8_SA(0, 0), a2, voffA);
            PG8_WAIT_V(8); PG8_WAIT_L(0); PG8_BAR; PG8_MMAB(1, 0, 1); PG8_BAR; PG8_SCHED;
            PG8_LDB(B0, 1, 0); PG8_LDB(B1, 1, 1); PG8_SCHED; PG8_LDA(At, 1, 0); PG8_STAGE_A(PG8_SA(0, 1), a2 + hstepA, voffA);
            PG8_WAIT_V(8); PG8_WAIT_L(0); PG8_BAR; PG8_MMAB(0, 1, 0); PG8_BAR; PG8_SCHED;
            PG8_LDA(At, 1, 1); PG8_STAGE_B(PG8_SB(1, 0), b3, voffB); PG8_STAGE_B(PG8_SB(1, 1), b3 + hstepB, voffB); PG8_STAGE_A(PG8_SA(1, 0), a3, voffA);
            PG8_WAIT_V(8); PG8_WAIT_L(0); PG8_BAR; PG8_MMAB(1, 1, 1); PG8_BAR; PG8_SCHED;
        }
        if constexpr (ALIGN_EPI) { if (wr == 0) PG8_BAR; }
        { const int l2 = lane_id(); E(acc, cur, wr, wc, l2 & 15, l2 >> 4); }
        if (!has_next) break;
#pragma unroll
        for (int a = 0; a < 2; ++a)
#pragma unroll
            for (int b = 0; b < 2; ++b)
#pragma unroll
                for (int m = 0; m < 4; ++m)
#pragma unroll
                    for (int n = 0; n < 2; ++n) acc[a][b][m][n] = (f32x4){0.f, 0.f, 0.f, 0.f};
        cur = nxt; cA = nA; cB = nB; ++ui;
        if constexpr (ALIGN_EPI) { if (wr == 1) PG8_BAR; }
    }
    PG8_WAIT_V(0);
    if constexpr (!ALIGN_EPI) { if (wr == 0) PG8_BAR; }
    PG8_BAR;
#undef PG8_SA
#undef PG8_SB
#undef PG8_STAGE_A
#undef PG8_STAGE_B
#undef PG8_LDA
#undef PG8_LDB
#undef PG8_MMA
#undef PG8_MMA8H
#undef PG8_MMAB
#undef PG8_LDA_HI
#undef PG8_WAIT_V
#undef PG8_WAIT_L
#undef PG8_BAR
#undef PG8_SCHED
#undef PG8_UA
#undef PG8_UB
}
}

#define XB_TMO      128
#define XB_XCNT(j)  (256  + 64 * (j))
#define XB_XSUB(j)  (1280 + 64 * (j))
#define XB_XGEN(j)  (2304 + 64 * (j))
#define XB_TOP      3328
#define XB_TOPGEN   3392
#define XCD_BAR_WORDS 3456
#define XB_SPIN_CAP (1u << 18)
__device__ __forceinline__ unsigned xb_ld(unsigned* p)              { return __hip_atomic_load(p, __ATOMIC_RELAXED, __HIP_MEMORY_SCOPE_AGENT); }
__device__ __forceinline__ unsigned xb_add(unsigned* p, unsigned v) { return __hip_atomic_fetch_add(p, v, __ATOMIC_RELAXED, __HIP_MEMORY_SCOPE_AGENT); }
__device__ __forceinline__ unsigned xb_xcc_id() { return (unsigned)__builtin_amdgcn_s_getreg((3 << 11) | 20) & 0xFu; }
#define XB_SPIN(cond, bar) do { unsigned _sp = 0; while (cond) { __builtin_amdgcn_s_sleep(1); \
    if ((++_sp & 255u) == 0u) { if (xb_ld(&(bar)[XB_TMO])) break; if (_sp > XB_SPIN_CAP) { atomicAdd(&(bar)[XB_TMO], 1u); break; } } } } while (0)
struct XcdBarrier { unsigned* bar; unsigned x; volatile LAS unsigned* st; };
__device__ __forceinline__ XcdBarrier xcd_barrier_post(unsigned* bar, volatile LAS unsigned* st) {
    XcdBarrier b; b.bar = bar; b.x = xb_xcc_id(); b.st = st;
    if (threadIdx.x == 0) (void)xb_add(&bar[XB_XCNT(b.x)], 1u);
    return b;
}
__device__ __forceinline__ void xcd_barrier_complete(unsigned* bar, unsigned x, unsigned& nloc, unsigned& nx) {
    const unsigned G = gridDim.x * gridDim.y * gridDim.z;
    unsigned sum, cnt, mine, sp = 0u;
    for (;;) {
        sum = 0u; cnt = 0u; mine = 0u;
#pragma unroll
        for (unsigned j = 0; j < 16; ++j) { const unsigned c = xb_ld(&bar[XB_XCNT(j)]); sum += c; cnt += (c > 0u) ? 1u : 0u; mine = (j == x) ? c : mine; }
        if (sum == G) break;
        __builtin_amdgcn_s_sleep(1);
        if ((++sp & 255u) == 0u) { if (xb_ld(&bar[XB_TMO])) break; if (sp > XB_SPIN_CAP) { atomicAdd(&bar[XB_TMO], 1u); break; } }
    }
    nloc = mine > 0u ? mine : 1u; nx = cnt > 0u ? cnt : 1u;
}
__device__ __forceinline__ void xcd_barrier(const XcdBarrier& b, const bool leader) {
    asm volatile("s_waitcnt vmcnt(0)" ::: "memory");
    __syncthreads();
    if (leader) {
        unsigned* bar = b.bar;
        __builtin_amdgcn_s_waitcnt(0);
        unsigned nloc = b.st[0], nx = b.st[1];
        if (nloc == 0u) { xcd_barrier_complete(bar, b.x, nloc, nx); b.st[0] = nloc; b.st[1] = nx; }
        const unsigned old = xb_add(&bar[XB_XSUB(b.x)], 1u);
        const unsigned gen = old / nloc;
        if (old + 1u == (gen + 1u) * nloc) {
            __builtin_amdgcn_fence(__ATOMIC_RELEASE, "agent");
            asm volatile("s_waitcnt vmcnt(0)" ::: "memory");
            const unsigned og = xb_add(&bar[XB_TOP], 1u);
            const unsigned tg = og / nx;
            if (og + 1u == (tg + 1u) * nx) xb_add(&bar[XB_TOPGEN], 1u);
            else XB_SPIN(xb_ld(&bar[XB_TOPGEN]) == tg, bar);
            __builtin_amdgcn_fence(__ATOMIC_ACQUIRE, "agent");
            xb_add(&bar[XB_XGEN(b.x)], 1u);
            asm volatile("s_waitcnt vmcnt(0)" ::: "memory");
        } else {
            XB_SPIN(xb_ld(&bar[XB_XGEN(b.x)]) == gen, bar);
            __builtin_amdgcn_fence(__ATOMIC_ACQUIRE, "agent");
            asm volatile("s_waitcnt vmcnt(0)" ::: "memory");
        }
    }
    __syncthreads();
}

constexpr int NWAVES = 8, NTHREADS = 512;
constexpr int RING_BYTES = 131072, LDSCTL_OFF = 139264, MISC_OFF = LDSCTL_OFF + 320, XCH_OFF = LDSCTL_OFF + 1024, LDS_BYTES = 147456;
constexpr int NPL = 12, N_PHASES = 1 + NPL * DEPTH;

struct Args { const float* in[17]; float* out; unsigned char* ws; int ph_lo, ph_hi; };
static_assert(sizeof(Args) == 17 * 8 + 8 + 8 + 8, "no padding");

struct Frame { LAS unsigned char* lds; int tid, lane, wave, G, gw, ngw; };
typedef __attribute__((address_space(4))) const unsigned char* kptr_t;
__device__ __forceinline__ kptr_t kbase() { kptr_t p = (kptr_t)__builtin_amdgcn_kernarg_segment_ptr(); asm volatile("" : "+s"(p)); return p; }
__device__ __forceinline__ const float* kin(int i) { return *(const float* const __attribute__((address_space(4)))*)(kbase() + 8 * i); }
__device__ __forceinline__ float* kout() { return *(float* const __attribute__((address_space(4)))*)(kbase() + 136); }
__device__ __forceinline__ unsigned char* kws() { return *(unsigned char* const __attribute__((address_space(4)))*)(kbase() + 144); }
__device__ __forceinline__ void refresh(Frame& F) { int t = F.wave * 64 + lane_id(); asm volatile("" : "+v"(t)); F.tid = t; F.lane = t & 63; F.gw = blockIdx.x * 8 + F.wave; }
enum { I_X = 0, I_META, I_NPM, I_NQM, I_NPF, I_NQF, I_WIN, I_BIF, I_GAIN, I_CMW, I_PW, I_PS, I_WBR, I_WOUT, I_WFFI, I_FCW, I_WFFO };

constexpr float W8_SCALE = 128.0f;
constexpr int WT_LD = 65, WT_BYTES = 64 * WT_LD * 4;
static_assert(8 * WT_BYTES <= LDSCTL_OFF, "weight tiles");
__device__ __forceinline__ void transpose_item64(const float* src, int ldw, unsigned char* dst, int ldb, bool f8, LAS float* scr, int lane) {
    const float* wp = src + lane;
    float v[64];
#pragma unroll
    for (int i = 0; i < 64; ++i) v[i] = __builtin_nontemporal_load(wp + (size_t)i * ldw);
#pragma unroll
    for (int i = 0; i < 64; ++i) scr[i * WT_LD + lane] = v[i];
    LDS_WAIT(); asm volatile("" ::: "memory");
    const int c = lane & 7;
#pragma unroll
    for (int j = 0; j < 8; ++j) { const int n = (lane >> 3) + 8 * j; const LAS float* s = scr + (8 * c) * WT_LD + n;
        if (!f8) { u32x4 o; o.x = pk2(s[0 * WT_LD], s[1 * WT_LD]); o.y = pk2(s[2 * WT_LD], s[3 * WT_LD]); o.z = pk2(s[4 * WT_LD], s[5 * WT_LD]); o.w = pk2(s[6 * WT_LD], s[7 * WT_LD]);
            *(u32x4*)(dst + (size_t)n * ldb + 16 * c) = o; }
        else { int p0 = 0, p1 = 0;
            p0 = __builtin_amdgcn_cvt_pk_fp8_f32(s[0 * WT_LD] * W8_SCALE, s[1 * WT_LD] * W8_SCALE, p0, false); p0 = __builtin_amdgcn_cvt_pk_fp8_f32(s[2 * WT_LD] * W8_SCALE, s[3 * WT_LD] * W8_SCALE, p0, true);
            p1 = __builtin_amdgcn_cvt_pk_fp8_f32(s[4 * WT_LD] * W8_SCALE, s[5 * WT_LD] * W8_SCALE, p1, false); p1 = __builtin_amdgcn_cvt_pk_fp8_f32(s[6 * WT_LD] * W8_SCALE, s[7 * WT_LD] * W8_SCALE, p1, true);
            u32x2 q; q.x = (unsigned)p0; q.y = (unsigned)p1; *(u32x2*)(dst + (size_t)n * ldb + 8 * c) = q; } }
    LDS_WAIT(); asm volatile("" ::: "memory");
}
__device__ __forceinline__ void weights_phase(Frame& F, int l) {
    LAS float* scr = (LAS float*)(F.lds + F.wave * WT_BYTES);
    unsigned char* ws = kws();
    bf16* Bt_in = (bf16*)(ws + WS_W + W_IN); bf16* Bt_br = (bf16*)(ws + WS_W + W_BR); bf16* Bt_out = (bf16*)(ws + WS_W + W_OUT); bf16* Bt_ffi = (bf16*)(ws + WS_W + W_FFI); bf16* Bt_ffo = (bf16*)(ws + WS_W + W_FFO);
    const float* w_in = kin(I_WIN) + (size_t)l * DM * INCOLS;
    const float* w_br = kin(I_WBR) + (size_t)l * 3 * MIXW * DM;
    const float* w_out = kin(I_WOUT) + (size_t)l * DM * DM;
    const float* w_ffi = kin(I_WFFI) + (size_t)l * DM * 2 * DFF;
    const float* w_ffo = kin(I_WFFO) + (size_t)l * DFF * DM;
    constexpr int G_IN = NIN / 64 + 1;
    constexpr int I_IN = G_IN * (DM / 64), I_BR = (DM / 64) * (3072 / 64), I_OUT = (DM / 64) * (DM / 64), I_FFI = (2 * DFF / 64) * (DM / 64), I_FFO = (DM / 64) * (DFF / 64);
    constexpr int NITEMS = I_IN + I_BR + I_OUT + I_FFI + I_FFO;
    for (int it = F.gw; it < NITEMS; it += F.ngw) {
        int r = it;
        if (r < I_IN) { const int kb = r / G_IN, nb = r % G_IN; const int drow = nb * 64, k0 = kb * 64;
            if (drow >= ZPU && drow < ZG) continue;
            const int scol = drow < 4096 ? drow : (drow < NIN ? drow + 16 : 4096);
            if (drow >= ZG && drow < NIN) { transpose_item64(w_in + (size_t)k0 * INCOLS + scol, INCOLS, (unsigned char*)(Bt_in + (size_t)ZG * DM) + (size_t)(drow - ZG) * DM + k0, DM, true, scr, F.lane); continue; }
            transpose_item64(w_in + (size_t)k0 * INCOLS + scol, INCOLS, (unsigned char*)Bt_in + ((size_t)drow * DM + k0) * 2, DM * 2, false, scr, F.lane); continue; } r -= I_IN;
        if (r < I_BR) { const int nblk = DM / 64, kb = r / nblk, nb = r % nblk; transpose_item64(w_br + (size_t)kb * 64 * DM + nb * 64, DM, (unsigned char*)Bt_br + ((size_t)nb * 64 * 3072 + kb * 64) * 2, 3072 * 2, false, scr, F.lane); continue; } r -= I_BR;
        if (r < I_OUT) { const int nblk = DM / 64, kb = r / nblk, nb = r % nblk; transpose_item64(w_out + (size_t)kb * 64 * DM + nb * 64, DM, (unsigned char*)Bt_out + ((size_t)nb * 64 * DM + kb * 64) * 2, DM * 2, false, scr, F.lane); continue; } r -= I_OUT;
        if (r < I_FFI) { const int nblk = 2 * DFF / 64, kb = r / nblk, nb = r % nblk; const int drow = nb * 64, tile = drow >> 8, wq = drow & 255;
            const int scol = wq < 128 ? tile * 128 + wq : DFF + tile * 128 + (wq - 128);
            transpose_item64(w_ffi + (size_t)kb * 64 * 2 * DFF + scol, 2 * DFF, (unsigned char*)Bt_ffi + ((size_t)drow * DM + kb * 64) * 2, DM * 2, false, scr, F.lane); continue; } r -= I_FFI;
        { const int nblk = DM / 64, kb = r / nblk, nb = r % nblk; transpose_item64(w_ffo + (size_t)kb * 64 * DM + nb * 64, DM, (unsigned char*)Bt_ffo + ((size_t)nb * 64 * DFF + kb * 64) * 2, DFF * 2, false, scr, F.lane); }
    }
    __syncthreads();
    const float* pw = kin(I_PW) + (size_t)l * 4 * 256 * 256; const float* ps = kin(I_PS) + (size_t)l * MIXW;
    LAS float* tile = (LAS float*)F.lds;
    for (int it = blockIdx.x; it < 4 * (DM / 32); it += F.G) {
        const int g = it & 3, k0 = (it >> 2) * 32;
        for (int e = F.tid; e < 32 * 256; e += NTHREADS) { const int kk = e >> 8, j = e & 255; tile[e] = w_in[(size_t)(k0 + kk) * INCOLS + 7184 + g * 256 + j]; }
        __syncthreads();
        const int c = F.tid & 255, kh = F.tid >> 8;
        float acc[16];
#pragma unroll
        for (int i = 0; i < 16; ++i) acc[i] = 0.f;
        for (int j = 0; j < 256; j += 4) { const float* pp = pw + ((size_t)g * 256 + j) * 256 + c; const float wa = pp[0], wb = pp[256], wc_ = pp[512], wd = pp[768];
#pragma unroll
            for (int i = 0; i < 16; ++i) { const f32x4 t = *(const LAS f32x4*)(tile + (kh * 16 + i) * 256 + j); acc[i] += (t[0] * wa + t[1] * wb) + (t[2] * wc_ + t[3] * wd); } }
        const float sc = ps[g * 256 + c];
        u32x4 o0, o1;
        o0.x = pk2(acc[0] * sc, acc[1] * sc); o0.y = pk2(acc[2] * sc, acc[3] * sc); o0.z = pk2(acc[4] * sc, acc[5] * sc); o0.w = pk2(acc[6] * sc, acc[7] * sc);
        o1.x = pk2(acc[8] * sc, acc[9] * sc); o1.y = pk2(acc[10] * sc, acc[11] * sc); o1.z = pk2(acc[12] * sc, acc[13] * sc); o1.w = pk2(acc[14] * sc, acc[15] * sc);
        bf16* dst = Bt_in + (size_t)(ZPU + g * 256 + c) * DM + k0 + kh * 16;
        *(u32x4*)dst = o0; *(u32x4*)(dst + 8) = o1;
        __syncthreads();
    }
}

__device__ __forceinline__ void store_h_row(bf16* hrow, unsigned char* h8row, const f32x4 (&v)[8], float r, const float* g, int lane) {
#pragma unroll
    for (int j = 0; j < 4; ++j) { const f32x4 ga = *(const f32x4*)(g + 8 * lane + 512 * j), gb = *(const f32x4*)(g + 8 * lane + 512 * j + 4);
        const f32x4 a = v[2 * j] * r * ga, b = v[2 * j + 1] * r * gb;
        u32x4 w; w.x = pk2(a[0], a[1]); w.y = pk2(a[2], a[3]); w.z = pk2(b[0], b[1]); w.w = pk2(b[2], b[3]);
        *(u32x4*)(hrow + 8 * lane + 512 * j) = w;
        if (h8row) { int p0 = 0, p1 = 0;
            p0 = __builtin_amdgcn_cvt_pk_fp8_f32(a[0], a[1], p0, false); p0 = __builtin_amdgcn_cvt_pk_fp8_f32(a[2], a[3], p0, true);
            p1 = __builtin_amdgcn_cvt_pk_fp8_f32(b[0], b[1], p1, false); p1 = __builtin_amdgcn_cvt_pk_fp8_f32(b[2], b[3], p1, true);
            u32x2 q; q.x = (unsigned)p0; q.y = (unsigned)p1; *(u32x2*)(h8row + 8 * lane + 512 * j) = q; } }
}
__device__ __forceinline__ float sumsq8(const f32x4 (&v)[8]) { float s = 0.f;
#pragma unroll
    for (int j = 0; j < 8; ++j) s += (v[j][0] * v[j][0] + v[j][1] * v[j][1]) + (v[j][2] * v[j][2] + v[j][3] * v[j][3]);
    return s; }
__device__ __forceinline__ void norm0_phase(Frame& F) {
    const float* x = kin(I_X); const float* meta = kin(I_META); const float* g = kin(I_NPM); unsigned char* ws = kws(); bf16* H = (bf16*)(ws + WS_H); unsigned char* H8 = ws + WS_H8;
    for (int row = F.gw; row < MT; row += F.ngw) {
        const float* xr = row < MR ? x + (size_t)row * DM : meta + (size_t)(row - MR) * DM;
        f32x4 v[8];
#pragma unroll
        for (int j = 0; j < 4; ++j) { v[2 * j] = *(const f32x4*)(xr + 8 * F.lane + 512 * j); v[2 * j + 1] = *(const f32x4*)(xr + 8 * F.lane + 512 * j + 4); }
        const float r = rsqrtf(wave_sum(sumsq8(v)) * (1.0f / DM) + RMS_EPS);
        store_h_row(H + (size_t)row * DM, H8 + (size_t)row * DM, v, r, g, F.lane);
    }
}
__device__ __forceinline__ void nrn_phase(Frame& F, const bf16* Y, const void* xin_real, bool in_bf16, const float* xin_meta, void* xout_real, bool out_bf16,
                                          const float* g_post, const float* g_next, bool want_h8) {
    unsigned char* ws = kws(); float* XM = (float*)(ws + WS_XM); bf16* H = (bf16*)(ws + WS_H); unsigned char* H8 = ws + WS_H8;
    for (int row = F.gw; row < MT; row += F.ngw) {
        const bf16* yr = Y + (size_t)row * DM;
        f32x4 y[8], x[8];
#pragma unroll
        for (int j = 0; j < 4; ++j) { const u32x4 w = *(const u32x4*)(yr + 8 * F.lane + 512 * j);
            y[2 * j] = (f32x4){bflo(w.x), bfhi(w.x), bflo(w.y), bfhi(w.y)}; y[2 * j + 1] = (f32x4){bflo(w.z), bfhi(w.z), bflo(w.w), bfhi(w.w)}; }
        if (row < MR && in_bf16) { const bf16* xr = (const bf16*)xin_real + (size_t)row * DM;
#pragma unroll
            for (int j = 0; j < 4; ++j) { const u32x4 w = *(const u32x4*)(xr + 8 * F.lane + 512 * j);
                x[2 * j] = (f32x4){bflo(w.x), bfhi(w.x), bflo(w.y), bfhi(w.y)}; x[2 * j + 1] = (f32x4){bflo(w.z), bfhi(w.z), bflo(w.w), bfhi(w.w)}; } }
        else { const float* xr = row < MR ? (const float*)xin_real + (size_t)row * DM : xin_meta + (size_t)(row - MR) * DM;
#pragma unroll
            for (int j = 0; j < 4; ++j) { x[2 * j] = *(const f32x4*)(xr + 8 * F.lane + 512 * j); x[2 * j + 1] = *(const f32x4*)(xr + 8 * F.lane + 512 * j + 4); } }
        const float r = rsqrtf(wave_sum(sumsq8(y)) * (1.0f / DM) + RMS_EPS);
#pragma unroll
        for (int j = 0; j < 4; ++j) { const f32x4 ga = *(const f32x4*)(g_post + 8 * F.lane + 512 * j), gb = *(const f32x4*)(g_post + 8 * F.lane + 512 * j + 4);
            x[2 * j] = x[2 * j] + y[2 * j] * r * ga; x[2 * j + 1] = x[2 * j + 1] + y[2 * j + 1] * r * gb; }
        if (row < MR && out_bf16) { bf16* xo = (bf16*)xout_real + (size_t)row * DM;
#pragma unroll
            for (int j = 0; j < 4; ++j) { u32x4 w; w.x = pk2(x[2 * j][0], x[2 * j][1]); w.y = pk2(x[2 * j][2], x[2 * j][3]); w.z = pk2(x[2 * j + 1][0], x[2 * j + 1][1]); w.w = pk2(x[2 * j + 1][2], x[2 * j + 1][3]);
                *(u32x4*)(xo + 8 * F.lane + 512 * j) = w; } }
        else { float* xo = row < MR ? (float*)xout_real + (size_t)row * DM : XM + (size_t)(row - MR) * DM;
#pragma unroll
            for (int j = 0; j < 4; ++j) { *(f32x4*)(xo + 8 * F.lane + 512 * j) = x[2 * j]; *(f32x4*)(xo + 8 * F.lane + 512 * j + 4) = x[2 * j + 1]; } }
        if (g_next) { const float r2 = rsqrtf(wave_sum(sumsq8(x)) * (1.0f / DM) + RMS_EPS); store_h_row(H + (size_t)row * DM, want_h8 ? H8 + (size_t)row * DM : (unsigned char*)nullptr, x, r2, g_next, F.lane); }
    }
}

__device__ __forceinline__ f32x4 thin_tile(const bf16* A, int lda, const bf16* Bt, int ldb, int K, int lane) {
    const bf16* ap = A + (size_t)(lane & 15) * lda + 8 * (lane >> 4);
    const bf16* bp = Bt + (size_t)(lane & 15) * ldb + 8 * (lane >> 4);
    f32x4 acc = {0.f, 0.f, 0.f, 0.f};
#pragma unroll 8
    for (int k = 0; k < K; k += 32) { const bf16x8 a = *(const bf16x8*)(ap + k); const bf16x8 b = *(const bf16x8*)(bp + k); acc = __builtin_amdgcn_mfma_f32_16x16x32_bf16(a, b, acc, 0, 0, 0); }
    return acc;
}

__device__ __forceinline__ f32x4 thin_part(const bf16* A, int lda, const bf16* Bt, int ldb, int k0, int klen, int lane) {
    const bf16* ap = A + (size_t)(lane & 15) * lda + 8 * (lane >> 4) + k0;
    const bf16* bp = Bt + (size_t)(lane & 15) * ldb + 8 * (lane >> 4) + k0;
    f32x4 acc = {0.f, 0.f, 0.f, 0.f};
#pragma unroll 16
    for (int k = 0; k < klen; k += 32) { const bf16x8 a = *(const bf16x8*)(ap + k); const bf16x8 b = *(const bf16x8*)(bp + k); acc = __builtin_amdgcn_mfma_f32_16x16x32_bf16(a, b, acc, 0, 0, 0); }
    return acc;
}
__device__ __forceinline__ f32x4 thin_part8(const unsigned char* A8, int lda, const unsigned char* B8, int ldb, int k0, int klen, int lane) {
    const unsigned char* ap = A8 + (size_t)(lane & 15) * lda + 32 * (lane >> 4) + k0;
    const unsigned char* bp = B8 + (size_t)(lane & 15) * ldb + 32 * (lane >> 4) + k0;
    f32x4 acc = {0.f, 0.f, 0.f, 0.f};
#pragma unroll 8
    for (int k = 0; k < klen; k += 128) { const pg8::v8i32 a = *(const pg8::v8i32*)(ap + k); const pg8::v8i32 b = *(const pg8::v8i32*)(bp + k);
        acc = __builtin_amdgcn_mfma_scale_f32_16x16x128_f8f6f4(a, b, acc, 0, 0, 0, 0x7f7f7f7f, 0, 0x7f7f7f7f); }
    return acc;
}
template <int NC, int KS, class Part, class Epi>
__device__ __forceinline__ void thin_wg(Frame& F, int ntiles, LAS f32x4* red, const Part& part, const Epi& epi) {
    static_assert(NC * KS == 8, "8 waves");
    const int sub = F.wave / KS, ks = F.wave % KS;
    for (int it = blockIdx.x; it * NC < ntiles; it += F.G) {
        const int ti = it * NC + sub;
        f32x4 acc = {0.f, 0.f, 0.f, 0.f};
        if (ti < ntiles) acc = part(ti, ks);
        red[F.wave * 64 + F.lane] = acc;
        __syncthreads();
        if (ks == 0 && ti < ntiles) {
#pragma unroll
            for (int j = 1; j < KS; ++j) acc += red[(F.wave + j) * 64 + F.lane];
            epi(ti, acc);
        }
        __syncthreads();
    }
}

typedef short s16x4 __attribute__((ext_vector_type(4)));
typedef short v4i16_t __attribute__((ext_vector_type(4)));
constexpr int DVE = 144, KS_RS = 272, VS_RS = 304, PM_RS = 144, RING_BYTES_C = 131072;
constexpr int NUNIT = 8 + NB * NHEAD * 64;
constexpr int USLOT = DVE * DHEAD;
constexpr size_t WS_SC = WS_IF + 1536 * 1024;
constexpr size_t WS_MC = WS_IF + 1792 * 1024;
static_assert((size_t)MT * 16 * 4 <= 1536 * 1024 && (size_t)NUNIT * USLOT * 2 <= 80 * MiB, "mlstm scratch");
__device__ __forceinline__ s16x4 tr16(const LAS unsigned char* p) { return __builtin_bit_cast(s16x4, __builtin_amdgcn_ds_read_tr16_b64_v4i16((LAS v4i16_t*)p)); }
__device__ __forceinline__ bf16x8 tr_frag(const LAS unsigned char* img, int RS, int ks, int c0, int lane) {
    const int g = lane >> 4, q = (lane & 15) >> 2, p = lane & 3;
    const LAS unsigned char* a = img + (32 * ks + 8 * g + q) * RS + c0 * 2 + 8 * p;
    const s16x4 lo = tr16(a), hi = tr16(a + 4 * RS);
    return __builtin_shufflevector(lo, hi, 0, 1, 2, 3, 4, 5, 6, 7);
}
__device__ __forceinline__ void unpack8(const u32x4 w, float (&f)[8]) { f[0] = bflo(w.x); f[1] = bfhi(w.x); f[2] = bflo(w.y); f[3] = bfhi(w.y); f[4] = bflo(w.z); f[5] = bfhi(w.z); f[6] = bflo(w.w); f[7] = bfhi(w.w); }
__device__ __forceinline__ u32x4 pack8(const float (&f)[8]) { u32x4 w; w.x = pk2(f[0], f[1]); w.y = pk2(f[2], f[3]); w.z = pk2(f[4], f[5]); w.w = pk2(f[6], f[7]); return w; }
__device__ __forceinline__ float logsigmoidf_(float x) {
    const float e = __builtin_amdgcn_exp2f(-1.4426950408889634f * fabsf(x));
    return fminf(x, 0.f) - 0.6931471805599453f * __builtin_amdgcn_logf(1.0f + e);
}
#define DPPX(oldv, srcv, CTRL, RM) __builtin_bit_cast(float, __builtin_amdgcn_update_dpp(__builtin_bit_cast(int, (float)(oldv)), __builtin_bit_cast(int, (float)(srcv)), (CTRL), (RM), 0xf, false))
__device__ __forceinline__ float wave_scan_add(float x, int) {
    x += DPPX(0.f, x, 0x111, 0xf); x += DPPX(0.f, x, 0x112, 0xf); x += DPPX(0.f, x, 0x114, 0xf); x += DPPX(0.f, x, 0x118, 0xf);
    x += DPPX(0.f, x, 0x142, 0xa); x += DPPX(0.f, x, 0x143, 0xc);
    return x;
}
__device__ __forceinline__ float wave_scan_max(float x, int) {
    const float ninf = -INFINITY;
    x = fmaxf(x, DPPX(ninf, x, 0x111, 0xf)); x = fmaxf(x, DPPX(ninf, x, 0x112, 0xf)); x = fmaxf(x, DPPX(ninf, x, 0x114, 0xf)); x = fmaxf(x, DPPX(ninf, x, 0x118, 0xf));
    x = fmaxf(x, DPPX(ninf, x, 0x142, 0xa)); x = fmaxf(x, DPPX(ninf, x, 0x143, 0xc));
    return x;
}
__device__ __forceinline__ void unit_decode(int u, int& b, int& h, int& T, int& row0, int& bh, int& c) {
    if (u < 8) { b = 0; h = u; T = NMETA; row0 = MR; bh = u; c = 0; }
    else { const int v = u - 8; const int c1 = v & 63; bh = v >> 6; h = bh & 7; b = bh >> 3; T = 64; row0 = b * SEQ + c1 * 64; c = c1 + 1; }
}
__device__ __forceinline__ void mlstm_u_phase(Frame& F, int l) {
    unsigned char* ws = kws(); const bf16* Z = (const bf16*)(ws + WS_Z); const float* IFb = (const float*)(ws + WS_IF); const float* b_if = kin(I_BIF);
    bf16* U = (bf16*)(ws + WS_MIX); float* SC = (float*)(ws + WS_SC);
    LAS unsigned char* ksm = F.lds; LAS unsigned char* vsm = F.lds + 64 * KS_RS;
    const int tid = F.tid, lane = F.lane, wave = F.wave;
    for (int u = blockIdx.x; u < NUNIT; u += F.G) {
        int b, h, T, row0, bh, c; unit_decode(u, b, h, T, row0, bh, c);
        const float bi = b_if[(l * 2 + 0) * NHEAD + h], bfv = b_if[(l * 2 + 1) * NHEAD + h];
        float li = 0.f, lfv = 0.f;
        if (lane < T) { li = IFb[(size_t)(row0 + lane) * 16 + h] + bi; lfv = logsigmoidf_(IFb[(size_t)(row0 + lane) * 16 + 8 + h] + bfv); }
        const float bcum = wave_scan_add(lfv, lane);
        const float a = lane < T ? li - bcum : -INFINITY;
        const float amax = __builtin_bit_cast(float, __builtin_amdgcn_readlane(__builtin_bit_cast(int, wave_scan_max(a, lane)), 63));
        const float bT = __builtin_bit_cast(float, __builtin_amdgcn_readlane(__builtin_bit_cast(int, bcum), 63));
        const float wsl = lane < T ? expf(a - amax) : 0.f;
        if (tid == 0) { SC[2 * u] = bT; SC[2 * u + 1] = amax; }
#pragma unroll
        for (int pi = 0; pi < 2; ++pi) {
            const int p = tid + NTHREADS * pi, s = p >> 4, d8 = (p & 15) * 8;
            float wv;
            { const int sb = 4 * wave + 32 * pi; const int wi = __builtin_bit_cast(int, wsl);
              const float r0 = __builtin_bit_cast(float, __builtin_amdgcn_readlane(wi, sb)), r1 = __builtin_bit_cast(float, __builtin_amdgcn_readlane(wi, sb + 1)),
                          r2 = __builtin_bit_cast(float, __builtin_amdgcn_readlane(wi, sb + 2)), r3 = __builtin_bit_cast(float, __builtin_amdgcn_readlane(wi, sb + 3));
              const int k = lane >> 4; wv = k == 0 ? r0 : (k == 1 ? r1 : (k == 2 ? r2 : r3)); }
            u32x4 kv = {0u, 0u, 0u, 0u}, vv = {0u, 0u, 0u, 0u};
            if (s < T) { const bf16* zr = Z + (size_t)(row0 + s) * ZP + h * DHEAD + d8; kv = *(const u32x4*)(zr + ZK); vv = *(const u32x4*)(zr + ZV); }
            *(LAS u32x4*)(ksm + s * KS_RS + d8 * 2) = kv;
            u32x4 sv; sv.x = pk2(bflo(vv.x) * wv, bfhi(vv.x) * wv); sv.y = pk2(bflo(vv.y) * wv, bfhi(vv.y) * wv); sv.z = pk2(bflo(vv.z) * wv, bfhi(vv.z) * wv); sv.w = pk2(bflo(vv.w) * wv, bfhi(vv.w) * wv);
            *(LAS u32x4*)(vsm + s * VS_RS + d8 * 2) = sv;
        }
        if (tid < 64) { const u32x4 o = {f2bf(wsl), 0u, 0u, 0u}; unsigned zz_; asm volatile("v_mov_b32 %0, 0" : "=v"(zz_)); const u32x4 z = {zz_, zz_, zz_, zz_};
            *(LAS u32x4*)(vsm + tid * VS_RS + 256) = o; *(LAS u32x4*)(vsm + tid * VS_RS + 272) = z; }
        __syncthreads();
        const bf16x8 A0 = tr_frag(ksm, KS_RS, 0, 16 * wave, lane), A1 = tr_frag(ksm, KS_RS, 1, 16 * wave, lane);
        bf16* Uu = U + (size_t)u * USLOT;
#pragma unroll
        for (int j = 0; j < 9; ++j) {
            const bf16x8 B0 = tr_frag(vsm, VS_RS, 0, 16 * j, lane), B1 = tr_frag(vsm, VS_RS, 1, 16 * j, lane);
            f32x4 acc = {0.f, 0.f, 0.f, 0.f};
            acc = __builtin_amdgcn_mfma_f32_16x16x32_bf16(A0, B0, acc, 0, 0, 0);
            acc = __builtin_amdgcn_mfma_f32_16x16x32_bf16(A1, B1, acc, 0, 0, 0);
            u32x2 o; o.x = pk2(acc[0], acc[1]); o.y = pk2(acc[2], acc[3]);
            *(u32x2*)(Uu + (16 * j + (lane & 15)) * DHEAD + 16 * wave + 4 * (lane >> 4)) = o;
        }
        __syncthreads();
    }
}
__device__ __forceinline__ void mlstm_scan_phase(Frame& F) {
    unsigned char* ws = kws(); bf16* U = (bf16*)(ws + WS_MIX); const float* SC = (const float*)(ws + WS_SC); float* MC = (float*)(ws + WS_MC);
    constexpr int OPS = USLOT / 8;
    for (int q = blockIdx.x * NTHREADS + F.tid; q < 32 * OPS; q += F.G * NTHREADS) {
        const int bh = q / OPS, idx = q - bh * OPS, h = bh & 7;
        float st[8], m = 0.f;
#pragma unroll
        for (int j = 0; j < 8; ++j) st[j] = 0.f;
        {
            float uf[8]; unpack8(*(const u32x4*)(U + (size_t)h * USLOT + idx * 8), uf); const float bT = SC[2 * h], amax = SC[2 * h + 1];
            if (idx == 0) MC[bh * 65] = 0.f;
            const float m1 = bT + fmaxf(m, amax), dec = expf(bT + m - m1), wu = expf(bT + amax - m1);
#pragma unroll
            for (int j = 0; j < 8; ++j) st[j] = dec * st[j] + wu * uf[j];
            m = m1;
        }
        for (int c0 = 0; c0 < 64; c0 += 16) {
            u32x4 uq[16]; float bT[16], am[16];
#pragma unroll
            for (int i = 0; i < 16; ++i) { const int unit = 8 + bh * 64 + c0 + i; uq[i] = *(const u32x4*)(U + (size_t)unit * USLOT + idx * 8); bT[i] = SC[2 * unit]; am[i] = SC[2 * unit + 1]; }
#pragma unroll
            for (int i = 0; i < 16; ++i) { const int unit = 8 + bh * 64 + c0 + i;
                *(u32x4*)(U + (size_t)unit * USLOT + idx * 8) = pack8(st);
                if (idx == 0) MC[bh * 65 + c0 + i + 1] = m;
                float uf[8]; unpack8(uq[i], uf);
                const float m1 = bT[i] + fmaxf(m, am[i]), dec = expf(bT[i] + m - m1), wu = expf(bT[i] + am[i] - m1);
#pragma unroll
                for (int j = 0; j < 8; ++j) st[j] = dec * st[j] + wu * uf[j];
                m = m1; }
        }
    }
}
#define BAR_LDS() do { asm volatile("s_waitcnt lgkmcnt(0)" ::: "memory"); __builtin_amdgcn_s_barrier(); asm volatile("" ::: "memory"); } while (0)
constexpr int KQ_RS = 272, OL_K = 0, OL_Q = 64 * KQ_RS, OL_C = 2 * 64 * KQ_RS, OL_V = OL_C + DVE * KQ_RS, OL_P = OL_V + 64 * VS_RS, OL_T = OL_P + 64 * PM_RS;
static_assert(OL_T + 8 * 256 <= RING_BYTES_C, "mlstm out LDS");
struct OutRegs { u32x4 pk[2], pq[2], pv[2], pc[5]; float li, xf, mc; };
__device__ __forceinline__ void out_issue(OutRegs& R, int u, int l, const bf16* Z, const float* IFb, const bf16* U, const float* MC, int tid, int lane, int wave) {
    int b, h, T, row0, bh, c; unit_decode(u, b, h, T, row0, bh, c);
    R.mc = u >= 8 ? MC[bh * 65 + c] : 0.f; R.li = 0.f; R.xf = 0.f;
    if (wave == 0 && lane < T) { R.li = IFb[(size_t)(row0 + lane) * 16 + h]; R.xf = IFb[(size_t)(row0 + lane) * 16 + 8 + h]; }
#pragma unroll
    for (int pi = 0; pi < 2; ++pi) { const int p = tid + NTHREADS * pi, s = p >> 4, d8 = (p & 15) * 8;
        R.pk[pi] = (u32x4){0u, 0u, 0u, 0u}; R.pq[pi] = R.pk[pi]; R.pv[pi] = R.pk[pi];
        if (s < T) { const bf16* zr = Z + (size_t)(row0 + s) * ZP + h * DHEAD + d8; R.pk[pi] = *(const u32x4*)(zr + ZK); R.pq[pi] = *(const u32x4*)(zr + ZQ); R.pv[pi] = *(const u32x4*)(zr + ZV); } }
    const bf16* Ct = U + (size_t)u * USLOT;
#pragma unroll
    for (int pi = 0; pi < 5; ++pi) { const int p = tid + NTHREADS * pi; R.pc[pi] = (u32x4){0u, 0u, 0u, 0u}; if (u >= 8 && p < DVE * 16) R.pc[pi] = *(const u32x4*)(Ct + p * 8); }
}
__device__ __forceinline__ void mlstm_out_phase(Frame& F, int l) {
    unsigned char* ws = kws(); const bf16* Z = (const bf16*)(ws + WS_Z); const float* IFb = (const float*)(ws + WS_IF); const float* b_if = kin(I_BIF);
    const bf16* U = (const bf16*)(ws + WS_MIX); const float* MC = (const float*)(ws + WS_MC); bf16* YS = (bf16*)(ws + WS_YS);
    const float* gain = kin(I_GAIN) + (size_t)l * MIXW;
    LAS unsigned char* ksm = F.lds + OL_K; LAS unsigned char* qsm = F.lds + OL_Q; LAS unsigned char* csm = F.lds + OL_C; LAS unsigned char* vsm = F.lds + OL_V; LAS unsigned char* Pm = F.lds + OL_P;
    LAS float* Atab = (LAS float*)(F.lds + OL_T); LAS float* MM = Atab + 64, *IWQ = MM + 64, *EM = IWQ + 64, *DEN = EM + 64, *SS = DEN + 64;
    const int tid = F.tid, lane = F.lane, wave = F.wave;
    const float qscale = 0.08838834764831845f;
    const int tt = wave & 3, js = wave >> 2, g = lane >> 4;
    OutRegs R;
    if ((int)blockIdx.x < NUNIT) out_issue(R, blockIdx.x, l, Z, IFb, U, MC, tid, lane, wave);
    for (int u = blockIdx.x; u < NUNIT; u += F.G) {
        int b, h, T, row0, bh, c; unit_decode(u, b, h, T, row0, bh, c);
        const bool has_state = u >= 8;
        const bool tvalid = 16 * tt < T;
        const int trow = 16 * tt + (lane & 15);
        if (wave == 0) {
            const float bi = b_if[(l * 2 + 0) * NHEAD + h], bfv = b_if[(l * 2 + 1) * NHEAD + h];
            const float lfv = lane < T ? logsigmoidf_(R.xf + bfv) : 0.f;
            const float bcum = wave_scan_add(lfv, lane);
            const float a = lane < T ? R.li + bi - bcum : -INFINITY;
            const float pm = wave_scan_max(a, lane);
            const float mm = fmaxf(R.mc, pm);
            Atab[lane] = a; MM[lane] = mm; IWQ[lane] = expf(R.mc - mm) * qscale; EM[lane] = expf(-(bcum + mm));
        }
#pragma unroll
        for (int pi = 0; pi < 2; ++pi) { const int p = tid + NTHREADS * pi, s = p >> 4, ch = p & 15;
            *(LAS u32x4*)(ksm + s * KQ_RS + ch * 16) = R.pk[pi]; *(LAS u32x4*)(qsm + s * KQ_RS + ch * 16) = R.pq[pi]; *(LAS u32x4*)(vsm + s * VS_RS + ch * 16) = R.pv[pi]; }
#pragma unroll
        for (int pi = 0; pi < 5; ++pi) { const int p = tid + NTHREADS * pi; if (p < DVE * 16) *(LAS u32x4*)(csm + (p >> 4) * KQ_RS + (p & 15) * 16) = R.pc[pi]; }
        if (tid < 64) { const u32x4 o = {tid < T ? 0x3f80u : 0u, 0u, 0u, 0u}; unsigned zz_; asm volatile("v_mov_b32 %0, 0" : "=v"(zz_)); const u32x4 z = {zz_, zz_, zz_, zz_};
            *(LAS u32x4*)(vsm + tid * VS_RS + 256) = o; *(LAS u32x4*)(vsm + tid * VS_RS + 272) = z; }
        BAR_LDS();
        if (u + F.G < NUNIT) out_issue(R, u + F.G, l, Z, IFb, U, MC, tid, lane, wave);
        u32x2 og[5];
#pragma unroll
        for (int jj = 0; jj < 5; ++jj) { const int j = js + 2 * jj; og[jj] = (u32x2){0u, 0u};
            if (tvalid && j < 8) og[jj] = *(const u32x2*)(Z + (size_t)(row0 + trow) * ZP + ZO + h * DHEAD + 16 * j + 4 * g); }
        bf16x8 Q[4];
#pragma unroll
        for (int ks = 0; ks < 4; ++ks) Q[ks] = *(const LAS bf16x8*)(qsm + trow * KQ_RS + 64 * ks + 16 * g);
#pragma unroll
        for (int i = 0; i < 2; ++i) {
            const int ts = 2 * js + i;
            u32x2 outp = {0u, 0u};
            if (tvalid && ts <= tt) {
                f32x4 acc = {0.f, 0.f, 0.f, 0.f};
#pragma unroll
                for (int ks = 0; ks < 4; ++ks) { const bf16x8 Ak = *(const LAS bf16x8*)(ksm + (16 * ts + (lane & 15)) * KQ_RS + 64 * ks + 16 * g); acc = __builtin_amdgcn_mfma_f32_16x16x32_bf16(Ak, Q[ks], acc, 0, 0, 0); }
                const float mmt = MM[trow];
                float pv[4];
#pragma unroll
                for (int i2 = 0; i2 < 4; ++i2) { const int s = 16 * ts + 4 * g + i2; pv[i2] = s <= trow ? acc[i2] * qscale * expf(Atab[s] - mmt) : 0.f; }
                outp.x = pk2(pv[0], pv[1]); outp.y = pk2(pv[2], pv[3]);
            }
            *(LAS u32x2*)(Pm + trow * PM_RS + (16 * ts + 4 * g) * 2) = outp;
        }
        BAR_LDS();
        f32x4 accs[5];
#pragma unroll
        for (int jj = 0; jj < 5; ++jj) accs[jj] = (f32x4){0.f, 0.f, 0.f, 0.f};
        if (tvalid) {
            const bf16x8 PB0 = *(const LAS bf16x8*)(Pm + trow * PM_RS + (8 * g) * 2), PB1 = *(const LAS bf16x8*)(Pm + trow * PM_RS + (32 + 8 * g) * 2);
            const float iwq = IWQ[trow];
#pragma unroll
            for (int jj = 0; jj < 5; ++jj) {
                const int j = js + 2 * jj;
                if (j <= 8) {
                    f32x4 acc = {0.f, 0.f, 0.f, 0.f};
                    if (has_state) {
#pragma unroll
                        for (int ks = 0; ks < 4; ++ks) { const bf16x8 Ac = *(const LAS bf16x8*)(csm + (16 * j + (lane & 15)) * KQ_RS + 64 * ks + 16 * g); acc = __builtin_amdgcn_mfma_f32_16x16x32_bf16(Ac, Q[ks], acc, 0, 0, 0); }
                        acc = acc * iwq;
                    }
                    { const bf16x8 Av = tr_frag(vsm, VS_RS, 0, 16 * j, lane); acc = __builtin_amdgcn_mfma_f32_16x16x32_bf16(Av, PB0, acc, 0, 0, 0); }
                    if (tt >= 2) { const bf16x8 Av = tr_frag(vsm, VS_RS, 1, 16 * j, lane); acc = __builtin_amdgcn_mfma_f32_16x16x32_bf16(Av, PB1, acc, 0, 0, 0); }
                    accs[jj] = acc;
                    if (j == 8 && g == 0) DEN[trow] = acc[0];
                }
            }
        }
        BAR_LDS();
        if (tvalid) {
            const float den = DEN[trow]; const float inv = 1.0f / fmaxf(fabsf(den), EM[trow]);
            float ssp = 0.f;
#pragma unroll
            for (int jj = 0; jj < 5; ++jj) { const int j = js + 2 * jj; if (j < 8) { accs[jj] = accs[jj] * inv; ssp += (accs[jj][0] * accs[jj][0] + accs[jj][1] * accs[jj][1]) + (accs[jj][2] * accs[jj][2] + accs[jj][3] * accs[jj][3]); } }
            ssp += __shfl_xor(ssp, 16); ssp += __shfl_xor(ssp, 32);
            if (g == 0) SS[js * 64 + trow] = ssp;
        }
        BAR_LDS();
        if (tvalid) {
            const float r = rsqrtf((SS[trow] + SS[64 + trow]) * (1.0f / DHEAD) + RMS_EPS);
            bf16* yr = YS + (size_t)(row0 + trow) * 3072 + h * DHEAD + 4 * g;
#pragma unroll
            for (int jj = 0; jj < 5; ++jj) { const int j = js + 2 * jj;
                if (j < 8) { const f32x4 gn = *(const f32x4*)(gain + h * DHEAD + 16 * j + 4 * g);
                    const float y0 = accs[jj][0] * r * gn[0] * sigmoidf_(bflo(og[jj].x)), y1 = accs[jj][1] * r * gn[1] * sigmoidf_(bfhi(og[jj].x));
                    const float y2 = accs[jj][2] * r * gn[2] * sigmoidf_(bflo(og[jj].y)), y3 = accs[jj][3] * r * gn[3] * sigmoidf_(bfhi(og[jj].y));
                    u32x2 w; w.x = pk2(y0, y1); w.y = pk2(y2, y3);
                    *(u32x2*)(yr + 16 * j) = w; } }
        }
        BAR_LDS();
    }
}

__device__ __forceinline__ void mix_phase(Frame& F, int l) {
    unsigned char* ws = kws(); const bf16* Z = (const bf16*)(ws + WS_Z); bf16* YS = (bf16*)(ws + WS_YS);
    const float* cw = kin(I_CMW) + (size_t)l * 3 * MIXW;
    const int sub = F.tid >> 7, tcol = F.tid & 127, c = 8 * tcol, win = 2 << (tcol >> 5);
    float w0[8], w1[8], w2[8];
#pragma unroll
    for (int j = 0; j < 8; ++j) { w0[j] = cw[c + j]; w1[j] = cw[MIXW + c + j]; w2[j] = cw[2 * MIXW + c + j]; }
    const u32x4 zero4 = {0u, 0u, 0u, 0u};
    for (int run = blockIdx.x * 4 + sub; run < MR / 16 + 1; run += F.G * 4) {
        int b, pos0; if (run < MR / 16) { b = run >> 8; pos0 = NMETA + (run & 255) * 16; } else { b = 0; pos0 = 0; }
        float S[8], z1[8], z2[8];
#pragma unroll
        for (int j = 0; j < 8; ++j) { S[j] = 0.f; z1[j] = 0.f; z2[j] = 0.f; }
        for (int k = 1; k <= 16; ++k) { if (k <= win && pos0 - k >= 0) { float f[8]; unpack8(*(const u32x4*)(Z + (size_t)prow(b, pos0 - k) * ZP + ZPU + c), f);
#pragma unroll
                for (int j = 0; j < 8; ++j) S[j] += f[j]; } }
        if (pos0 >= 1) { const bf16* zz = Z + (size_t)prow(b, pos0 - 1) * ZP; float a[8], x[8]; unpack8(*(const u32x4*)(zz + ZCC + c), a); unpack8(*(const u32x4*)(zz + ZCX + c), x);
#pragma unroll
            for (int j = 0; j < 8; ++j) z1[j] = a[j] * x[j]; }
        if (pos0 >= 2) { const bf16* zz = Z + (size_t)prow(b, pos0 - 2) * ZP; float a[8], x[8]; unpack8(*(const u32x4*)(zz + ZCC + c), a); unpack8(*(const u32x4*)(zz + ZCX + c), x);
#pragma unroll
            for (int j = 0; j < 8; ++j) z2[j] = a[j] * x[j]; }
        for (int t0 = 0; t0 < 16; t0 += 4) {
            u32x4 cbw[4], ccw[4], cxw[4], puw[4], olw[4];
#pragma unroll
            for (int i = 0; i < 4; ++i) { const int pos = pos0 + t0 + i; const bf16* zr = Z + (size_t)prow(b, pos) * ZP;
                cbw[i] = *(const u32x4*)(zr + ZCB + c); ccw[i] = *(const u32x4*)(zr + ZCC + c); cxw[i] = *(const u32x4*)(zr + ZCX + c); puw[i] = *(const u32x4*)(zr + ZPU + c);
                olw[i] = pos - win >= 0 ? *(const u32x4*)(Z + (size_t)prow(b, pos - win) * ZP + ZPU + c) : zero4; }
#pragma unroll
            for (int i = 0; i < 4; ++i) { const int pos = pos0 + t0 + i; const int row = prow(b, pos);
                float cb[8], cc[8], cx[8], pu[8], ol[8], yb[8], yc[8];
                unpack8(cbw[i], cb); unpack8(ccw[i], cc); unpack8(cxw[i], cx); unpack8(puw[i], pu); unpack8(olw[i], ol);
                const int cnt = pos + 1 < win ? pos + 1 : win; const float inv = 1.0f / (float)cnt;
#pragma unroll
                for (int j = 0; j < 8; ++j) { const float zc = cc[j] * cx[j];
                    yb[j] = cb[j] * (w0[j] * z2[j] + w1[j] * z1[j] + w2[j] * zc); z2[j] = z1[j]; z1[j] = zc;
                    S[j] += pu[j] - ol[j]; yc[j] = S[j] * inv - pu[j]; }
                bf16* yr = YS + (size_t)row * 3072;
                *(u32x4*)(yr + MIXW + c) = pack8(yb); *(u32x4*)(yr + 2 * MIXW + c) = pack8(yc);
            }
        }
    }
}

__device__ __forceinline__ void act_fix_phase(Frame& F, int l) {
    unsigned char* ws = kws(); const float* EA = (const float*)(ws + WS_EA); const float* EU = (const float*)(ws + WS_EU); const float* AUM = (const float*)(ws + WS_AUM); bf16* ACT = (bf16*)(ws + WS_ACT);
    const float* cw = kin(I_FCW) + (size_t)l * 3 * DFF;
    constexpr int NROWS = 64 * 2 + NMETA;
    for (int e = blockIdx.x * NTHREADS + F.tid; e < NROWS * DFF; e += F.G * NTHREADS) {
        const int ri = e / DFF, c = e - ri * DFF; const int cm = (c >> 7) * 256 + (c & 127);
        float a0 = 0.f, a1 = 0.f, a2, uu; int row;
        if (ri < 128) { const int pm = ri >> 1, j = ri & 1; row = pm * 256 + j;
            a2 = EA[((size_t)pm * 4 + 2 + j) * DFF + c]; uu = EU[((size_t)pm * 2 + j) * DFF + c];
            float p255, p254;
            if ((pm & 15) == 0) { p255 = AUM[(size_t)15 * 2 * DFF + cm]; p254 = AUM[(size_t)14 * 2 * DFF + cm]; }
            else { p255 = EA[((size_t)(pm - 1) * 4 + 1) * DFF + c]; p254 = EA[((size_t)(pm - 1) * 4 + 0) * DFF + c]; }
            if (j == 0) { a1 = p255; a0 = p254; } else { a1 = EA[((size_t)pm * 4 + 2) * DFF + c]; a0 = p255; }
        } else { const int p = ri - 128; row = MR + p;
            a2 = AUM[(size_t)p * 2 * DFF + cm]; uu = AUM[(size_t)p * 2 * DFF + cm + 128];
            if (p >= 1) a1 = AUM[(size_t)(p - 1) * 2 * DFF + cm]; if (p >= 2) a0 = AUM[(size_t)(p - 2) * 2 * DFF + cm]; }
        const float cv = cw[c] * a0 + cw[DFF + c] * a1 + cw[2 * DFF + c] * a2;
        ACT[(size_t)row * DFF + c] = (bf16)f2bf(gelu_tanh(cv) * uu);
    }
}

#define WSP(T, off) ((T*)(ws + (off)))
__global__ void __launch_bounds__(NTHREADS, 2) fwd(Args args_unused) {
    extern __shared__ __attribute__((aligned(16))) unsigned char lds_raw[];
    Frame F;
    F.lds = (LAS unsigned char*)lds_raw;
    F.tid = threadIdx.x; F.lane = F.tid & 63; F.wave = __builtin_amdgcn_readfirstlane(F.tid >> 6);
    F.G = gridDim.x; F.gw = blockIdx.x * NWAVES + F.wave; F.ngw = F.G * NWAVES;
    volatile LAS unsigned* MISC = (volatile LAS unsigned*)(F.lds + MISC_OFF);
    for (int u = F.tid; u < (LDS_BYTES - LDSCTL_OFF) / 4; u += NTHREADS) ((LAS unsigned*)(F.lds + LDSCTL_OFF))[u] = 0u;
    __syncthreads();
    int lo, hi; { kptr_t kb = kbase(); lo = *(const int __attribute__((address_space(4)))*)(kb + 152); hi = *(const int __attribute__((address_space(4)))*)(kb + 156); }
    const bool multi = (hi - lo) > 1;
    if (multi) (void)xcd_barrier_post((unsigned*)(kws() + WS_CTL) + CW_BAR, MISC + 8);
#ifndef PH_MASK
#define PH_MASK 0x1fff
#endif
#define IN(k) (lo <= (k) && (k) < hi)
#define PM(k) ((PH_MASK >> (k)) & 1)
#ifndef REP_MASK
#define REP_MASK 0
#endif
#define NREP(k) (((REP_MASK >> (k)) & 1) ? 2 : 1)
#define SEAM(k) do { if (IN(k) && IN((k) + 1)) { XcdBarrier bar_; bar_.bar = (unsigned*)(kws() + WS_CTL) + CW_BAR; bar_.x = xb_xcc_id(); bar_.st = (volatile LAS unsigned*)(F.lds + MISC_OFF) + 8; xcd_barrier(bar_, F.wave == 0 && lane_id() == 0); } } while (0)

    if (PM(0) && IN(0)) { for (int rep = 0; rep < NREP(0); ++rep) weights_phase(F, 0); norm0_phase(F); SEAM(0); }

    for (int l = 0; l < DEPTH; ++l) {
        const int pb = 1 + NPL * l;
#define REFRESH() refresh(F)
        if (PM(1) && IN(pb + 0)) { REFRESH();
            unsigned char* ws = kws();
            const bf16* H = WSP(const bf16, WS_H); const bf16* Bt_in = WSP(const bf16, WS_W + W_IN); bf16* Z = WSP(bf16, WS_Z); float* IFb = WSP(float, WS_IF);
            const unsigned char* H8 = WSP(const unsigned char, WS_H8); const unsigned char* Bt_g8 = (const unsigned char*)(Bt_in + (size_t)ZG * DM);
            {
                pg8::Gemm g{H, Bt_in, DM, DM, DM}; pg8::OrderStd S; S.init(MR, ZG, F.G, (int)blockIdx.x);
                pg8::EpiBf16 E{Z, ZP, 1 << 30, 1.0f};
                for (int rep = 0; rep < NREP(1); ++rep)
                pg8::gemm_phase<pg8::EpiBf16, pg8::OrderStd, true>(F.lds, g, S, E, F.wave);
            }
            {
                pg8::Gemm g{(const bf16*)H8, (const bf16*)Bt_g8, DM / 2, DM / 2, DM / 2}; pg8::OrderStd S; S.init(MR, 3 * DM, F.G, (int)blockIdx.x);
                pg8::EpiGate E{WSP(unsigned char, WS_GT), 1.0f / W8_SCALE};
                for (int rep = 0; rep < NREP(5); ++rep)
                pg8::gemm_phase<pg8::EpiGate, pg8::OrderStd, true, true>(F.lds, g, S, E, F.wave);
            }
            LAS f32x4* red = (LAS f32x4*)F.lds;
            constexpr int T_IF = MT / 16, T_MB = ZG / 16, T_MG = 3 * DM / 16;
            thin_wg<4, 2>(F, T_IF + T_MB + T_MG, red,
                [&](int ti, int ks) { if (ti < T_IF) return thin_part(H + (size_t)ti * 16 * DM, DM, Bt_in + (size_t)NIN * DM, DM, ks * (DM / 2), DM / 2, F.lane);
                    ti -= T_IF; if (ti < T_MB) return thin_part(H + (size_t)MR * DM, DM, Bt_in + (size_t)ti * 16 * DM, DM, ks * (DM / 2), DM / 2, F.lane);
                    ti -= T_MB; return thin_part8(H8 + (size_t)MR * DM, DM, Bt_g8 + (size_t)ti * 16 * DM, DM, ks * (DM / 2), DM / 2, F.lane); },
                [&](int ti, f32x4 a) {
                    if (ti < T_IF) {
#pragma unroll
                        for (int i = 0; i < 4; ++i) IFb[(size_t)(ti * 16 + 4 * (F.lane >> 4) + i) * 16 + (F.lane & 15)] = a[i];
                        return; }
                    ti -= T_IF;
                    if (ti < T_MB) { const int col = ti * 16 + (F.lane & 15);
#pragma unroll
                        for (int i = 0; i < 4; ++i) { const int row = MR + 4 * (F.lane >> 4) + i; Z[(size_t)row * ZP + col] = (bf16)f2bf(a[i]); }
                        return; }
                    ti -= T_MB; { const int col = ti * 16 + (F.lane & 15); bf16* GM = WSP(bf16, WS_GM);
#pragma unroll
                        for (int i = 0; i < 4; ++i) GM[(4 * (F.lane >> 4) + i) * (3 * DM) + col] = (bf16)f2bf(sigmoidf_(a[i] * (1.0f / W8_SCALE))); } });
            SEAM(pb + 0);
        }
        if (PM(2) && IN(pb + 1)) { REFRESH(); for (int rep = 0; rep < NREP(2); ++rep) mlstm_u_phase(F, l); for (int rep = 0; rep < NREP(5); ++rep) mix_phase(F, l); SEAM(pb + 1); }
        if (PM(3) && IN(pb + 2)) { REFRESH(); mlstm_scan_phase(F); SEAM(pb + 2); }
        if (PM(4) && IN(pb + 3)) { REFRESH(); for (int rep = 0; rep < NREP(4); ++rep) mlstm_out_phase(F, l); SEAM(pb + 3); }
        if (PM(6) && IN(pb + 5)) { REFRESH();
            unsigned char* ws = kws();
            const bf16* YS = WSP(const bf16, WS_YS); const bf16* Bt_br = WSP(const bf16, WS_W + W_BR); const bf16* GM = WSP(const bf16, WS_GM); bf16* MG = WSP(bf16, WS_MG);
            pg8::Gemm g{YS, Bt_br, 3072, 3072, 3072}; pg8::OrderStd S; S.init(MR, DM, F.G, (int)blockIdx.x);
            pg8::EpiBranch E{WSP(const unsigned char, WS_GT), MG};
            for (int rep = 0; rep < NREP(6); ++rep)
            pg8::gemm_phase<pg8::EpiBranch, pg8::OrderStd, true>(F.lds, g, S, E, F.wave);
            thin_wg<1, 8>(F, DM / 16, (LAS f32x4*)F.lds,
                [&](int ti, int ks) { const int col = ti * 16 + (F.lane & 15); f32x4 tot = {0.f, 0.f, 0.f, 0.f};
#pragma unroll
                    for (int n = 0; n < 3; ++n) { const f32x4 a = thin_part(YS + (size_t)MR * 3072 + n * MIXW, 3072, Bt_br + (size_t)ti * 16 * 3072 + n * MIXW, 3072, ks * (MIXW / 8), MIXW / 8, F.lane);
#pragma unroll
                        for (int i = 0; i < 4; ++i) tot[i] += a[i] * bf2f(GM[(4 * (F.lane >> 4) + i) * (3 * DM) + n * DM + col]); }
                    return tot; },
                [&](int ti, f32x4 a) { const int col = ti * 16 + (F.lane & 15);
#pragma unroll
                    for (int i = 0; i < 4; ++i) MG[(size_t)(MR + 4 * (F.lane >> 4) + i) * DM + col] = (bf16)f2bf(a[i]); });
            SEAM(pb + 5);
        }
        if (PM(7) && IN(pb + 6)) { REFRESH();
            unsigned char* ws = kws();
            const bf16* MG = WSP(const bf16, WS_MG); const bf16* Bt_out = WSP(const bf16, WS_W + W_OUT); bf16* MIX = WSP(bf16, WS_MIX);
            pg8::Gemm g{MG, Bt_out, DM, DM, DM}; pg8::OrderStd S; S.init(MR, DM, F.G, (int)blockIdx.x);
            pg8::EpiBf16 E{MIX, DM, 1 << 30, 1.0f};
            for (int rep = 0; rep < NREP(7); ++rep)
            pg8::gemm_phase<pg8::EpiBf16, pg8::OrderStd, true>(F.lds, g, S, E, F.wave);
            thin_wg<1, 8>(F, DM / 16, (LAS f32x4*)F.lds,
                [&](int ti, int ks) { return thin_part(MG + (size_t)MR * DM, DM, Bt_out + (size_t)ti * 16 * DM, DM, ks * (DM / 8), DM / 8, F.lane); },
                [&](int ti, f32x4 a) {
#pragma unroll
                    for (int i = 0; i < 4; ++i) MIX[(size_t)(MR + 4 * (F.lane >> 4) + i) * DM + ti * 16 + (F.lane & 15)] = (bf16)f2bf(a[i]); });
            SEAM(pb + 6);
        }
        if (PM(8) && IN(pb + 7)) { REFRESH();
            unsigned char* ws = kws();
            for (int rep = 0; rep < (l == 0 ? NREP(8) : 1); ++rep)
            nrn_phase(F, WSP(const bf16, WS_MIX), l == 0 ? (const void*)kin(I_X) : (const void*)kout(), l != 0, l == 0 ? kin(I_META) : WSP(const float, WS_XM), WSP(void, WS_XB), true, kin(I_NQM) + (size_t)l * DM, kin(I_NPF) + (size_t)l * DM, false);
            SEAM(pb + 7);
        }
        if (PM(9) && IN(pb + 8)) { REFRESH();
            unsigned char* ws = kws();
            const bf16* H = WSP(const bf16, WS_H); const bf16* Bt_ffi = WSP(const bf16, WS_W + W_FFI); float* AUM = WSP(float, WS_AUM);
            pg8::Gemm g{H, Bt_ffi, DM, DM, DM}; pg8::OrderStd S; S.init(MR, 2 * DFF, F.G, (int)blockIdx.x);
            pg8::EpiAct E{WSP(bf16, WS_ACT), WSP(float, WS_EA), WSP(float, WS_EU), kin(I_FCW) + (size_t)l * 3 * DFF, (LAS float*)(F.lds + XCH_OFF)};
            for (int rep = 0; rep < NREP(9); ++rep)
            pg8::gemm_phase<pg8::EpiAct, pg8::OrderStd, true>(F.lds, g, S, E, F.wave);
            thin_wg<4, 2>(F, 2 * DFF / 16, (LAS f32x4*)F.lds,
                [&](int ti, int ks) { return thin_part(H + (size_t)MR * DM, DM, Bt_ffi + (size_t)ti * 16 * DM, DM, ks * (DM / 2), DM / 2, F.lane); },
                [&](int ti, f32x4 a) {
#pragma unroll
                    for (int i = 0; i < 4; ++i) AUM[(size_t)(4 * (F.lane >> 4) + i) * (2 * DFF) + ti * 16 + (F.lane & 15)] = a[i]; });
            SEAM(pb + 8);
        }
        if (PM(10) && IN(pb + 9)) { REFRESH(); act_fix_phase(F, l); SEAM(pb + 9); }
        if (PM(11) && IN(pb + 10)) { REFRESH();
            unsigned char* ws = kws();
            const bf16* ACT = WSP(const bf16, WS_ACT); const bf16* Bt_ffo = WSP(const bf16, WS_W + W_FFO); bf16* MIX = WSP(bf16, WS_MIX);
            pg8::Gemm g{ACT, Bt_ffo, DFF, DFF, DFF}; pg8::OrderStd S; S.init(MR, DM, F.G, (int)blockIdx.x);
            pg8::EpiBf16 E{MIX, DM, 1 << 30, 1.0f};
            for (int rep = 0; rep < NREP(11); ++rep)
            pg8::gemm_phase<pg8::EpiBf16, pg8::OrderStd, true>(F.lds, g, S, E, F.wave);
            thin_wg<1, 8>(F, DM / 16, (LAS f32x4*)F.lds,
                [&](int ti, int ks) { return thin_part(ACT + (size_t)MR * DFF, DFF, Bt_ffo + (size_t)ti * 16 * DFF, DFF, ks * (DFF / 8), DFF / 8, F.lane); },
                [&](int ti, f32x4 a) {
#pragma unroll
                    for (int i = 0; i < 4; ++i) MIX[(size_t)(MR + 4 * (F.lane >> 4) + i) * DM + ti * 16 + (F.lane & 15)] = (bf16)f2bf(a[i]); });
            SEAM(pb + 10);
        }
        if (PM(12) && IN(pb + 11)) { REFRESH();
            unsigned char* ws = kws();
            nrn_phase(F, WSP(const bf16, WS_MIX), WSP(const void, WS_XB), true, WSP(const float, WS_XM), (void*)kout(), l + 1 < DEPTH, kin(I_NQF) + (size_t)l * DM, l + 1 < DEPTH ? kin(I_NPM) + (size_t)(l + 1) * DM : nullptr, true);
            if (l + 1 < DEPTH) weights_phase(F, l + 1);
            SEAM(pb + 11);
        }
    }
#undef IN
#undef SEAM
}

#ifndef N_LAUNCH_SPLIT
#define N_LAUNCH_SPLIT 0
#endif
extern "C" void kernel_launch(void* const* d_in, const int* in_sizes, int n_in, void* d_out, int out_size, void* d_ws, size_t ws_size, hipStream_t stream) {
    static int grid = 0;
    if (grid == 0) {
        if (n_in != 17 || out_size != MR * DM || ws_size < WS_END) { fprintf(stderr, "kernel_launch: unexpected sizes n_in %d out %d ws %zu (need %zu)\n", n_in, out_size, ws_size, (size_t)WS_END); grid = -1; return; }
        int dev = 0, cus = 0, per_cu = 0;
        if (hipGetDevice(&dev) != hipSuccess || hipDeviceGetAttribute(&cus, hipDeviceAttributeMultiprocessorCount, dev) != hipSuccess) { grid = -1; return; }
        if (hipFuncSetAttribute((const void*)fwd, hipFuncAttributeMaxDynamicSharedMemorySize, LDS_BYTES) != hipSuccess) { fprintf(stderr, "kernel_launch: hipFuncSetAttribute failed\n"); grid = -1; return; }
        if (hipOccupancyMaxActiveBlocksPerMultiprocessor(&per_cu, (const void*)fwd, NTHREADS, LDS_BYTES) != hipSuccess || per_cu < 1) { fprintf(stderr, "kernel_launch: occupancy query says %d\n", per_cu); }
        (void)hipGetLastError();
        grid = cus;
    }
    if (grid < 0) return;
    (void)hipMemsetAsync((char*)d_ws + WS_CTL, 0, CTL_ZERO_BYTES, stream);
    Args a{};
    for (int i = 0; i < 17; ++i) a.in[i] = (const float*)d_in[i];
    a.out = (float*)d_out; a.ws = (unsigned char*)d_ws;
#if N_LAUNCH_SPLIT
    for (int p = 0; p < N_PHASES; ++p) { a.ph_lo = p; a.ph_hi = p + 1; hipLaunchKernelGGL(fwd, dim3(grid), dim3(NTHREADS), LDS_BYTES, stream, a); }
#else
    a.ph_lo = 0; a.ph_hi = N_PHASES; hipLaunchKernelGGL(fwd, dim3(grid), dim3(NTHREADS), LDS_BYTES, stream, a);
#endif
}
```

```cpp
#include <hip/hip_runtime.h>
#include <cstdio>
#include <cstdint>

#define LAS __attribute__((address_space(3)))
#define GAS __attribute__((address_space(1)))
typedef unsigned short bf16;
typedef short bf16x8 __attribute__((ext_vector_type(8)));
typedef float f32x4 __attribute__((ext_vector_type(4)));
typedef float f32x2 __attribute__((ext_vector_type(2)));
typedef unsigned u32x4 __attribute__((ext_vector_type(4)));
typedef unsigned u32x2 __attribute__((ext_vector_type(2)));
typedef GAS unsigned gu32;

constexpr int DM = 2048, NB = 4, SEQ = 4096, NMETA = 16, MIXW = 1024, NHEAD = 8, DHEAD = 128, DFF = 5632, DEPTH = 2;
constexpr int MR = NB * SEQ;
constexpr int MT = MR + NMETA;
constexpr int NIN = 14336;
constexpr int INCOLS = 14352;
constexpr int ZP = 8256;
constexpr int NIN_ROWS = 14400;
constexpr float RMS_EPS = 1e-6f;
constexpr int ZQ = 0, ZK = 1024, ZV = 2048, ZO = 3072, ZCB = 4096, ZCC = 5120, ZCX = 6144, ZPU = 7168, ZG = 8192;

constexpr size_t MiB = 1u << 20;
constexpr size_t WS_CTL = 0, CTL_ZERO_BYTES = 64 * 1024;
constexpr size_t WS_IF = 1 * MiB;
constexpr size_t WS_XM = 3 * MiB;
constexpr size_t WS_GM = 3 * MiB + 256 * 1024;
constexpr size_t WS_W = 4 * MiB;
constexpr size_t W_IN = 0, W_BR = W_IN + (size_t)NIN_ROWS * DM * 2, W_OUT = W_BR + (size_t)DM * 3072 * 2, W_FFI = W_OUT + (size_t)DM * DM * 2,
                 W_FFO = W_FFI + (size_t)2 * DFF * DM * 2, W_END = W_FFO + (size_t)DM * DFF * 2;
static_assert(W_END <= 143 * MiB, "weights");
constexpr size_t WS_Z = 147 * MiB;
constexpr size_t WS_GT = 406 * MiB;
constexpr size_t WS_ACT = WS_Z;
constexpr size_t WS_EA = WS_Z + 180 * MiB;
constexpr size_t WS_EU = WS_Z + 188 * MiB;
constexpr size_t WS_AUM = WS_Z + 192 * MiB;
constexpr size_t WS_YS = 598 * MiB;
constexpr size_t WS_H = WS_YS;
constexpr size_t WS_H8 = WS_YS + (size_t)MT * DM * 2;

constexpr size_t WS_MG = 695 * MiB;
constexpr size_t WS_XB = WS_MG;
constexpr size_t WS_MIX = 760 * MiB;
constexpr size_t WS_END = 840 * MiB;
static_assert(WS_H + (size_t)MT * DM * 2 <= WS_H8 && WS_H8 + (size_t)MT * DM <= WS_MG, "H8");
static_assert(WS_Z + (size_t)MT * ZP * 2 <= WS_GT && WS_GT + (size_t)64 * 24 * 65536 <= WS_YS && WS_ACT + (size_t)MT * DFF * 2 <= WS_EA && WS_EA + (size_t)64 * 4 * DFF * 4 <= WS_EU && WS_EU + (size_t)64 * 2 * DFF * 4 <= WS_AUM && WS_AUM + (size_t)16 * 2 * DFF * 4 <= WS_YS, "map1");
static_assert(WS_YS + (size_t)MT * 3072 * 2 <= WS_MG && WS_MG + (size_t)MT * DM * 2 <= WS_MIX && WS_MIX + (size_t)80 * MiB <= WS_END && (size_t)MT * DM * 2 <= 80 * MiB, "map2");
constexpr int CW_BAR = 4096;

__device__ __forceinline__ unsigned f2bf(float f) { unsigned u = __builtin_bit_cast(unsigned, f); return (u + 0x7fffu + ((u >> 16) & 1u)) >> 16; }
__device__ __forceinline__ unsigned pk2(float lo, float hi) { return f2bf(lo) | (f2bf(hi) << 16); }
__device__ __forceinline__ float bf2f(bf16 b) { return __builtin_bit_cast(float, (unsigned)b << 16); }
__device__ __forceinline__ float bflo(unsigned w) { return __builtin_bit_cast(float, w << 16); }
__device__ __forceinline__ float bfhi(unsigned w) { return __builtin_bit_cast(float, w & 0xffff0000u); }
__device__ __forceinline__ float sigmoidf_(float x) { return __builtin_amdgcn_rcpf(1.0f + __builtin_amdgcn_exp2f(-1.4426950408889634f * x)); }
__device__ __forceinline__ float wave_sum(float v) {
#pragma unroll
    for (int o = 1; o < 64; o <<= 1) v += __shfl_xor(v, o);
    return v;
}
__device__ __forceinline__ float gelu_tanh(float x) {
    const float p = x * __builtin_fmaf(0.1029432396f * x, x, 2.3022081981f);
    return x * __builtin_amdgcn_rcpf(1.0f + __builtin_amdgcn_exp2f(-p));
}
__device__ __forceinline__ int prow(int b, int pos) { return pos < NMETA ? MR + pos : b * SEQ + pos - NMETA; }
__device__ __forceinline__ int lane_id() { int l; asm volatile("v_mbcnt_lo_u32_b32 %0, -1, 0\n\tv_mbcnt_hi_u32_b32 %0, -1, %0" : "=v"(l)); return l; }
#define LDS_WAIT() asm volatile("s_waitcnt lgkmcnt(0)" ::: "memory")
#define VM_WAIT() asm volatile("s_waitcnt vmcnt(0)" ::: "memory")

namespace pg8 {
constexpr int BM = 256, BK = 64, HALF = 128, HTB = HALF * BK * 2, STAGE_BYTES = 8 * HTB, NXCD = 8, WGM = 8;
__host__ __device__ __forceinline__ int lds_byte(int r, int c) { const int st = (r >> 4) * 2 + (c >> 5), rr = r & 15, cc = c & 31, ob = rr * 64 + cc * 2; return st * 1024 + (ob ^ (((ob >> 9) & 1) << 5)); }
__host__ __device__ __forceinline__ void stage_rc(int b, int& R, int& C) { const int st = b / 1024, sb = b % 1024, swz = sb ^ (((sb >> 9) & 1) << 5); R = (st >> 1) * 16 + swz / 64; C = (st & 1) * 32 + (swz % 64) / 2; }
__host__ __device__ __forceinline__ int perm32(int rho) { const int n = rho >> 4, i = rho & 15; return 8 * (i >> 2) + 4 * n + (i & 3); }

typedef int v8i32 __attribute__((ext_vector_type(8)));
typedef int v4i32 __attribute__((ext_vector_type(4)));
__device__ __forceinline__ v8i32 cat8(const bf16x8 a, const bf16x8 b) { const v4i32 x = __builtin_bit_cast(v4i32, a), y = __builtin_bit_cast(v4i32, b); return __builtin_shufflevector(x, y, 0, 1, 2, 3, 4, 5, 6, 7); }
struct Unit { int pm, pn; };
struct Gemm { const bf16* A; const bf16* Bt; int lda, ldb, K; };

__device__ __forceinline__ void tile_of(int wgid, int nM, int nN, int& pm, int& pn) {
    const int nwg = nM * nN;
    { const int q = nwg / NXCD, r = nwg % NXCD, xcd = wgid % NXCD, off = wgid / NXCD; wgid = (xcd < r ? xcd * (q + 1) : r * (q + 1) + (xcd - r) * q) + off; }
    const int nig = WGM * nN, gid = wgid / nig, fm = gid * WGM, gsz = (nM - fm) < WGM ? (nM - fm) : WGM;
    pm = fm + ((wgid % nig) % gsz); pn = (wgid % nig) / gsz;
}
struct OrderStd {
    int nM, nN, nwg, G, c;
    __device__ void init(int M, int N, int G_, int c_) { nM = M / BM; nN = N / BM; nwg = nM * nN; G = G_; c = c_; }
    __device__ bool next(int i, Unit& u) const {
        const long L = (long)i * G + c; if (L >= nwg) return false;
        tile_of((int)L, nM, nN, u.pm, u.pn); return true;
    }
};
__device__ __forceinline__ unsigned cvt_pk_bf16(float lo, float hi) { unsigned r; asm volatile("v_cvt_pk_bf16_f32 %0, %1, %2" : "=v"(r) : "v"(lo), "v"(hi)); return r; }

struct EpiF32 {
    static constexpr bool PERM = false, HAS_MID = false;
    float* C; int ldc;
    __device__ __forceinline__ void operator()(const f32x4 (&acc)[2][2][4][2], const Unit& u, int wr, int wc, int fr, int fq) const {
        const int row0 = u.pm * BM + wr * 64 + fr, col0 = u.pn * BM + wc * 32 + 4 * fq;
#pragma unroll
        for (int ai = 0; ai < 2; ++ai)
#pragma unroll
            for (int m = 0; m < 4; ++m) { float* rowp = C + (size_t)(row0 + ai * HALF + m * 16) * ldc + col0;
#pragma unroll
                for (int bj = 0; bj < 2; ++bj)
#pragma unroll
                    for (int n = 0; n < 2; ++n) *(f32x4*)(rowp + bj * HALF + n * 16) = acc[ai][bj][m][n]; }
    }
};
struct EpiBf16 {
    static constexpr bool PERM = true, HAS_MID = false;
    bf16* O; int ldc; int gate_pn; float gscale;
    __device__ __forceinline__ void operator()(const f32x4 (&acc)[2][2][4][2], const Unit& u, int wr, int wc, int fr, int fq) const {
        const int row0 = u.pm * BM + wr * 64 + fr, col0 = u.pn * BM + wc * 32 + 8 * fq;
        const bool gate = u.pn >= gate_pn;
#pragma unroll
        for (int ai = 0; ai < 2; ++ai)
#pragma unroll
            for (int m = 0; m < 4; ++m) { bf16* rowp = O + (size_t)(row0 + ai * HALF + m * 16) * ldc + col0;
#pragma unroll
                for (int bj = 0; bj < 2; ++bj) { f32x4 v0 = acc[ai][bj][m][0], v1 = acc[ai][bj][m][1];
                    if (gate) {
#pragma unroll
                        for (int j = 0; j < 4; ++j) { v0[j] = sigmoidf_(v0[j] * gscale); v1[j] = sigmoidf_(v1[j] * gscale); } }
                    u32x4 w; w.x = cvt_pk_bf16(v0[0], v0[1]); w.y = cvt_pk_bf16(v0[2], v0[3]); w.z = cvt_pk_bf16(v1[0], v1[1]); w.w = cvt_pk_bf16(v1[2], v1[3]);
                    *(u32x4*)(rowp + bj * HALF) = w; } }
    }
};
constexpr int GT_COLS = 24;
__device__ __forceinline__ float ub0(unsigned x) { return (float)(x & 0xffu); }
__device__ __forceinline__ float ub1(unsigned x) { return (float)((x >> 8) & 0xffu); }
__device__ __forceinline__ float ub2(unsigned x) { return (float)((x >> 16) & 0xffu); }
__device__ __forceinline__ float ub3(unsigned x) { return (float)(x >> 24); }
struct EpiGate {
    static constexpr bool PERM = true, HAS_MID = false;
    unsigned char* G; float gscale;
    static __device__ __forceinline__ unsigned q4(const f32x4 v, float gs) {
        const float c = -1.4426950409f * gs; const f32x2 cc = {c, c}, one = {1.0f, 1.0f};
        const f32x2 ta = (f32x2){v[0], v[1]} * cc, tb = (f32x2){v[2], v[3]} * cc;
        const f32x2 da = (f32x2){__builtin_amdgcn_exp2f(ta[0]), __builtin_amdgcn_exp2f(ta[1])} + one, db = (f32x2){__builtin_amdgcn_exp2f(tb[0]), __builtin_amdgcn_exp2f(tb[1])} + one;
        const unsigned y0 = __builtin_bit_cast(unsigned, __builtin_fmaf(__builtin_amdgcn_rcpf(da[0]), 255.0f, 12582912.0f)), y1 = __builtin_bit_cast(unsigned, __builtin_fmaf(__builtin_amdgcn_rcpf(da[1]), 255.0f, 12582912.0f));
        const unsigned y2 = __builtin_bit_cast(unsigned, __builtin_fmaf(__builtin_amdgcn_rcpf(db[0]), 255.0f, 12582912.0f)), y3 = __builtin_bit_cast(unsigned, __builtin_fmaf(__builtin_amdgcn_rcpf(db[1]), 255.0f, 12582912.0f));
        const unsigned p01 = __builtin_amdgcn_perm(y1, y0, 0x0c0c0400u), p23 = __builtin_amdgcn_perm(y3, y2, 0x0c0c0400u);
        return __builtin_amdgcn_perm(p23, p01, 0x05040100u); }
    __device__ __forceinline__ void operator()(const f32x4 (&acc)[2][2][4][2], const Unit& u, int wr, int wc, int fr, int fq) const {
        unsigned char* base = G + ((size_t)(u.pm * GT_COLS + u.pn) << 16) + ((((wr * 4 + wc) * 64) + fq * 16 + fr) << 4);
#pragma unroll
        for (int ai = 0; ai < 2; ++ai)
#pragma unroll
            for (int m = 0; m < 4; ++m) { u32x4 w;
                w.x = q4(acc[ai][0][m][0], gscale); w.y = q4(acc[ai][0][m][1], gscale); w.z = q4(acc[ai][1][m][0], gscale); w.w = q4(acc[ai][1][m][1], gscale);
                *(u32x4*)(base + ((ai * 4 + m) << 13)) = w; }
    }
};
struct EpiBranch {
    static constexpr bool PERM = true, HAS_MID = true;
    const unsigned char* Gt;
    bf16* MG;
    static __device__ __forceinline__ float fl(float g) { return fmaxf(g, 1e-30f); }
    static __device__ __forceinline__ void rs4(f32x4& v, unsigned a, unsigned b) {
        v[0] *= fl(ub0(a)) * __builtin_amdgcn_rcpf(fl(ub0(b))); v[1] *= fl(ub1(a)) * __builtin_amdgcn_rcpf(fl(ub1(b)));
        v[2] *= fl(ub2(a)) * __builtin_amdgcn_rcpf(fl(ub2(b))); v[3] *= fl(ub3(a)) * __builtin_amdgcn_rcpf(fl(ub3(b))); }
    __device__ __forceinline__ void mid(f32x4 (&acc)[2][2][4][2], const Unit& u, int sidx, int wr, int wc, int fr, int fq) const {
        asm volatile("" : "+v"(fr), "+v"(fq));
        const unsigned char* gp = Gt + ((size_t)(u.pm * GT_COLS + (sidx - 1) * 8 + u.pn) << 16) + ((((wr * 4 + wc) * 64) + fq * 16 + fr) << 4);
#pragma unroll
        for (int ai = 0; ai < 2; ++ai) {
#pragma unroll
            for (int m = 0; m < 4; ++m) { const int so = (ai * 4 + m) << 13;
                const u32x4 ga = *(const u32x4*)(gp + so), gb = *(const u32x4*)(gp + ((size_t)8 << 16) + so);
                rs4(acc[ai][0][m][0], ga.x, gb.x); rs4(acc[ai][0][m][1], ga.y, gb.y); rs4(acc[ai][1][m][0], ga.z, gb.z); rs4(acc[ai][1][m][1], ga.w, gb.w); }
            asm volatile("" ::: "memory"); }
        asm volatile("s_waitcnt vmcnt(0)" ::: "memory");
    }
    static __device__ __forceinline__ unsigned fin4(const f32x4 v, unsigned g, bool hi) {
        const float s = 1.0f / 255.0f;
        return hi ? cvt_pk_bf16(v[2] * (fl(ub2(g)) * s), v[3] * (fl(ub3(g)) * s)) : cvt_pk_bf16(v[0] * (fl(ub0(g)) * s), v[1] * (fl(ub1(g)) * s)); }
    __device__ __forceinline__ void operator()(const f32x4 (&acc)[2][2][4][2], const Unit& u, int wr, int wc, int fr, int fq) const {
        asm volatile("" : "+v"(fr), "+v"(fq));
        const int row0 = u.pm * BM + wr * 64 + fr, col0 = u.pn * BM + wc * 32 + 8 * fq;
        const unsigned char* gp = Gt + ((size_t)(u.pm * GT_COLS + 16 + u.pn) << 16) + ((((wr * 4 + wc) * 64) + fq * 16 + fr) << 4);
#pragma unroll
        for (int ai = 0; ai < 2; ++ai)
#pragma unroll
            for (int m = 0; m < 4; ++m) { const size_t r = (size_t)(row0 + ai * HALF + m * 16);
                const u32x4 g = *(const u32x4*)(gp + ((ai * 4 + m) << 13));
                u32x4 w0, w1;
                w0.x = fin4(acc[ai][0][m][0], g.x, false); w0.y = fin4(acc[ai][0][m][0], g.x, true); w0.z = fin4(acc[ai][0][m][1], g.y, false); w0.w = fin4(acc[ai][0][m][1], g.y, true);
                w1.x = fin4(acc[ai][1][m][0], g.z, false); w1.y = fin4(acc[ai][1][m][0], g.z, true); w1.z = fin4(acc[ai][1][m][1], g.w, false); w1.w = fin4(acc[ai][1][m][1], g.w, true);
                *(u32x4*)(MG + r * DM + col0) = w0; *(u32x4*)(MG + r * DM + col0 + HALF) = w1; }
    }
};

#define DPPZ(srcv, CTRL) __builtin_bit_cast(float, __builtin_amdgcn_mov_dpp(__builtin_bit_cast(int, (float)(srcv)), (CTRL), 0xf, 0xf, true))
#define DPPF(oldv, srcv, CTRL) __builtin_bit_cast(float, __builtin_amdgcn_mov_dpp(__builtin_bit_cast(int, (float)(srcv)), (CTRL), 0xf, 0xf, false))
#define DPPO(oldv, srcv, CTRL) __builtin_bit_cast(float, __builtin_amdgcn_update_dpp(__builtin_bit_cast(int, (float)(oldv)), __builtin_bit_cast(int, (float)(srcv)), (CTRL), 0xf, 0xf, false))
struct EpiAct {
    static constexpr bool PERM = true, HAS_MID = false;
    bf16* ACT; float* EA; float* EU; const float* cw; LAS float* X;
    __device__ __forceinline__ void operator()(const f32x4 (&acc)[2][2][4][2], const Unit& u, int wr, int wc, int fr, int fq) const {
        asm volatile("" : "+v"(fr), "+v"(fq));
        const int cl = wc * 32 + 8 * fq;
        const int cbase = u.pn * 128 + cl;
        float w0[8], w1[8], w2[8];
        { const f32x4 t0 = *(const f32x4*)(cw + cbase), t1 = *(const f32x4*)(cw + cbase + 4), t2 = *(const f32x4*)(cw + DFF + cbase), t3 = *(const f32x4*)(cw + DFF + cbase + 4),
                      t4 = *(const f32x4*)(cw + 2 * DFF + cbase), t5 = *(const f32x4*)(cw + 2 * DFF + cbase + 4);
#pragma unroll
          for (int j = 0; j < 4; ++j) { w0[j] = t0[j]; w0[4 + j] = t1[j]; w1[j] = t2[j]; w1[4 + j] = t3[j]; w2[j] = t4[j]; w2[4 + j] = t5[j]; } }
        if (fr >= 14) {
#pragma unroll
            for (int ai = 0; ai < 2; ++ai) { LAS float* xp = X + ((ai * 2 + wr) * 2 + (fr - 14)) * 128 + cl; *(LAS f32x4*)xp = acc[ai][0][3][0]; *(LAS f32x4*)(xp + 4) = acc[ai][0][3][1]; }
            if (wr == 1) { float* ep = EA + ((size_t)u.pm * 4 + (fr - 14)) * DFF + cbase; *(f32x4*)ep = acc[1][0][3][0]; *(f32x4*)(ep + 4) = acc[1][0][3][1]; }
        }
        if (fr < 2 && wr == 0) {
            float* ep = EA + ((size_t)u.pm * 4 + 2 + fr) * DFF + cbase; *(f32x4*)ep = acc[0][0][0][0]; *(f32x4*)(ep + 4) = acc[0][0][0][1];
            float* up = EU + ((size_t)u.pm * 2 + fr) * DFF + cbase; *(f32x4*)up = acc[0][1][0][0]; *(f32x4*)(up + 4) = acc[0][1][0][1];
        }
        asm volatile("s_waitcnt lgkmcnt(0)" ::: "memory"); __builtin_amdgcn_s_barrier(); asm volatile("" ::: "memory");
#pragma unroll
        for (int ai = 0; ai < 2; ++ai) {
            f32x4 pa = {0.f, 0.f, 0.f, 0.f}, pb = {0.f, 0.f, 0.f, 0.f};
            if (fr >= 14 && (wr == 1 || ai == 1)) { const int sai = wr == 1 ? ai : ai - 1, swr = wr == 1 ? 0 : 1;
                const LAS float* xp = X + ((sai * 2 + swr) * 2 + (fr - 14)) * 128 + cl; pa = *(const LAS f32x4*)xp; pb = *(const LAS f32x4*)(xp + 4); }
#pragma unroll
            for (int m = 0; m < 4; ++m) {
                float o[8];
#pragma unroll
                for (int j = 0; j < 8; j += 2) {
                    f32x2 cur, uu, x1, x2;
#pragma unroll
                    for (int e = 0; e < 2; ++e) { const int jj = j + e;
                        const float c = jj < 4 ? acc[ai][0][m][0][jj & 3] : acc[ai][0][m][1][jj & 3];
                        const float prv = m == 0 ? (jj < 4 ? pa[jj & 3] : pb[jj & 3]) : (jj < 4 ? acc[ai][0][m - 1][0][jj & 3] : acc[ai][0][m - 1][1][jj & 3]);
                        const float r1 = DPPF(0.f, prv, 0x121), r2 = DPPF(0.f, prv, 0x122);
                        cur[e] = c; uu[e] = jj < 4 ? acc[ai][1][m][0][jj & 3] : acc[ai][1][m][1][jj & 3];
                        x1[e] = DPPO(r1, c, 0x111); x2[e] = DPPO(r2, c, 0x112); }
                    const f32x2 W0 = {w0[j], w0[j + 1]}, W1 = {w1[j], w1[j + 1]}, W2 = {w2[j], w2[j + 1]};
                    const f32x2 cv = __builtin_elementwise_fma(W1, x1, __builtin_elementwise_fma(W0, x2, W2 * cur));
                    const f32x2 pp = __builtin_elementwise_fma(cv * cv, (f32x2){0.1029432396f, 0.1029432396f}, (f32x2){2.3022081981f, 2.3022081981f});
                    const f32x2 ee = -cv * pp;
                    f32x2 dd = {__builtin_amdgcn_exp2f(ee[0]), __builtin_amdgcn_exp2f(ee[1])}; dd = dd + (f32x2){1.0f, 1.0f};
                    const f32x2 rr = {__builtin_amdgcn_rcpf(dd[0]), __builtin_amdgcn_rcpf(dd[1])};
                    const f32x2 oo = (cv * rr) * uu;
                    o[j] = oo[0]; o[j + 1] = oo[1];
                }
                u32x4 w; w.x = cvt_pk_bf16(o[0], o[1]); w.y = cvt_pk_bf16(o[2], o[3]); w.z = cvt_pk_bf16(o[4], o[5]); w.w = cvt_pk_bf16(o[6], o[7]);
                *(u32x4*)(ACT + (size_t)(u.pm * BM + ai * HALF + wr * 64 + m * 16 + fr) * DFF + cbase) = w;
            }
        }
    }
};

template <class Epi, class Sched, bool ALIGN_EPI, bool F8 = false>
__device__ __forceinline__ void gemm_phase(LAS unsigned char* lds, const Gemm g, const Sched& S, const Epi& E, const int wave_id) {
    int tid_ = wave_id * 64 + lane_id(); asm volatile("" : "+v"(tid_));
    const int tid = tid_, wid = __builtin_amdgcn_readfirstlane(tid >> 6), lane = tid & 63, wr = wid >> 2, wc = wid & 3, fr = lane & 15, fq = lane >> 4;
    const int K = g.K, nt = K / BK;
    unsigned voffA[2], voffB[2];
#pragma unroll
    for (int i = 0; i < 2; ++i) { int R, C; stage_rc(tid * 16 + i * 8192, R, C); const int Rb = Epi::PERM ? ((R & ~31) + perm32(R & 31)) : R;
        voffA[i] = (unsigned)(R * g.lda + C) * 2u; voffB[i] = (unsigned)(Rb * g.ldb + C) * 2u; }
    const unsigned kstep = (unsigned)(BK * 2);
    const unsigned hstepA = (unsigned)HALF * g.lda * 2u, hstepB = (unsigned)HALF * g.ldb * 2u;
    const auto rsA = __builtin_amdgcn_make_buffer_rsrc((void*)g.A, 0, 0x7fffffff, 0x00020000);
    const auto rsB = __builtin_amdgcn_make_buffer_rsrc((void*)g.Bt, 0, 0x7fffffff, 0x00020000);
    const unsigned ldsw = (unsigned)wid * 1024u;
    const int aoff = lds_byte(wr * 64 + fr, fq * 8), boff = lds_byte(wc * 32 + fr, fq * 8);
#define PG8_SA(b, h) (((b) * 2 + (h)) * HTB)
#define PG8_SB(b, h) ((4 + (b) * 2 + (h)) * HTB)
#define PG8_STAGE_A(bufoff, soff, voff) do { _Pragma("unroll") for (int _i = 0; _i < 2; ++_i) \
        __builtin_amdgcn_raw_ptr_buffer_load_lds(rsA, (LAS unsigned*)(lds + (bufoff) + ldsw + _i * 8192), 16, (voff)[_i], (int)(soff), 0, 0); } while (0)
#define PG8_STAGE_B(bufoff, soff, voff) do { _Pragma("unroll") for (int _i = 0; _i < 2; ++_i) \
        __builtin_amdgcn_raw_ptr_buffer_load_lds(rsB, (LAS unsigned*)(lds + (bufoff) + ldsw + _i * 8192), 16, (voff)[_i], (int)(soff), 0, 0); } while (0)
#define PG8_LDA(dst, b, h) do { if constexpr (F8) { _Pragma("unroll") for (int m = 0; m < 2; ++m) dst##8[m] = cat8(*(const LAS bf16x8*)(lds + PG8_SA(b, h) + aoff + m * 2048), *(const LAS bf16x8*)(lds + PG8_SA(b, h) + aoff + m * 2048 + 1024)); } \
        else { _Pragma("unroll") for (int m = 0; m < 4; ++m) _Pragma("unroll") for (int k = 0; k < 2; ++k) dst[m][k] = *(const LAS bf16x8*)(lds + PG8_SA(b, h) + aoff + m * 2048 + k * 1024); } } while (0)
#define PG8_LDA_HI(dst, b, h) do { _Pragma("unroll") for (int m = 0; m < 2; ++m) dst##8[m] = cat8(*(const LAS bf16x8*)(lds + PG8_SA(b, h) + aoff + (m + 2) * 2048), *(const LAS bf16x8*)(lds + PG8_SA(b, h) + aoff + (m + 2) * 2048 + 1024)); } while (0)
#define PG8_LDB(dst, b, h) do { _Pragma("unroll") for (int n = 0; n < 2; ++n) { if constexpr (F8) dst##8[n] = cat8(*(const LAS bf16x8*)(lds + PG8_SB(b, h) + boff + n * 2048), *(const LAS bf16x8*)(lds + PG8_SB(b, h) + boff + n * 2048 + 1024)); \
        else { _Pragma("unroll") for (int k = 0; k < 2; ++k) dst[n][k] = *(const LAS bf16x8*)(lds + PG8_SB(b, h) + boff + n * 2048 + k * 1024); } } } while (0)
#define PG8_MMA(ai, bj, At, Bt) do { __builtin_amdgcn_s_setprio(1); _Pragma("unroll") for (int m = 0; m < 4; ++m) _Pragma("unroll") for (int n = 0; n < 2; ++n) _Pragma("unroll") for (int k = 0; k < 2; ++k) \
        acc[ai][bj][m][n] = __builtin_amdgcn_mfma_f32_16x16x32_bf16(Bt[n][k], At[m][k], acc[ai][bj][m][n], 0, 0, 0); __builtin_amdgcn_s_setprio(0); } while (0)
#define PG8_MMA8H(ai, mb) do { __builtin_amdgcn_s_setprio(1); _Pragma("unroll") for (int m = 0; m < 2; ++m) _Pragma("unroll") for (int n = 0; n < 2; ++n) { \
        acc[ai][0][mb + m][n] = __builtin_amdgcn_mfma_scale_f32_16x16x128_f8f6f4(B08[n], At8[m], acc[ai][0][mb + m][n], 0, 0, 0, sc8, 0, sc8); \
        acc[ai][1][mb + m][n] = __builtin_amdgcn_mfma_scale_f32_16x16x128_f8f6f4(B18[n], At8[m], acc[ai][1][mb + m][n], 0, 0, 0, sc8, 0, sc8); } __builtin_amdgcn_s_setprio(0); } while (0)
#define PG8_MMAB(ai, b, h) do { if constexpr (F8) { PG8_MMA8H(ai, 0); PG8_LDA_HI(At, b, h); PG8_MMA8H(ai, 2); } else { PG8_MMA(ai, 0, At, B0); PG8_MMA(ai, 1, At, B1); } } while (0)
#define PG8_WAIT_V(n) asm volatile("s_waitcnt vmcnt(" #n ")" ::: "memory")
#define PG8_WAIT_L(n) asm volatile("s_waitcnt lgkmcnt(" #n ")" ::: "memory")
#define PG8_BAR __builtin_amdgcn_s_barrier()
#define PG8_SCHED __builtin_amdgcn_sched_barrier(0)
#define PG8_UA(u) (((unsigned)(u).pm * BM * g.lda) * 2u)
#define PG8_UB(u) (((unsigned)(u).pn * BM * g.ldb) * 2u)
    Unit cur, nxt; int ui = 0;
    if (!S.next(0, cur)) return;
    f32x4 acc[2][2][4][2];
#pragma unroll
    for (int a = 0; a < 2; ++a)
#pragma unroll
        for (int b = 0; b < 2; ++b)
#pragma unroll
            for (int m = 0; m < 4; ++m)
#pragma unroll
                for (int n = 0; n < 2; ++n) acc[a][b][m][n] = (f32x4){0.f, 0.f, 0.f, 0.f};
    int sc8 = 0x7f7f7f7f; if constexpr (F8) asm volatile("" : "+s"(sc8));
    bf16x8 At[4][2], B0[2][2], B1[2][2]; v8i32 At8[2], B08[2], B18[2];
    unsigned cA = PG8_UA(cur), cB = PG8_UB(cur);
    PG8_STAGE_B(PG8_SB(0, 0), cB, voffB); PG8_STAGE_B(PG8_SB(0, 1), cB + hstepB, voffB); PG8_STAGE_A(PG8_SA(0, 0), cA, voffA); PG8_STAGE_A(PG8_SA(0, 1), cA + hstepA, voffA);
    if (wr == 1) PG8_BAR;
    PG8_WAIT_V(2); PG8_BAR;
    PG8_STAGE_B(PG8_SB(1, 0), cB + kstep, voffB); PG8_STAGE_A(PG8_SA(1, 0), cA + kstep, voffA); PG8_STAGE_B(PG8_SB(1, 1), cB + hstepB + kstep, voffB);
    PG8_WAIT_V(6); PG8_BAR;
    for (;;) {
        const bool has_next = S.next(ui + 1, nxt);
        const unsigned nA = has_next ? PG8_UA(nxt) : cA, nB = has_next ? PG8_UB(nxt) : cB;
        for (int t = 0; t < nt; t += 2) {
            const bool last = (t == nt - 2);
            const unsigned a1 = cA + (unsigned)(t + 1) * kstep;
            const unsigned a2 = last ? nA : cA + (unsigned)(t + 2) * kstep, b2 = last ? nB : cB + (unsigned)(t + 2) * kstep;
            const unsigned a3 = a2 + kstep, b3 = b2 + kstep;
            if constexpr (Epi::HAS_MID) { if (t == 16 || t == 32) { if (wr == 0) PG8_BAR; { const int l2 = lane_id(); E.mid(acc, cur, t >> 4, wr, wc, l2 & 15, l2 >> 4); } if (wr == 1) PG8_BAR; } }
            PG8_LDB(B0, 0, 0); PG8_LDB(B1, 0, 1); PG8_SCHED; PG8_LDA(At, 0, 0); PG8_STAGE_A(PG8_SA(1, 1), a1 + hstepA, voffA);
            PG8_WAIT_V(8); PG8_WAIT_L(0); PG8_BAR; PG8_MMAB(0, 0, 0); PG8_BAR; PG8_SCHED;
            PG8_LDA(At, 0, 1); PG8_STAGE_B(PG8_SB(0, 0), b2, voffB); PG8_STAGE_B(PG8_SB(0, 1), b2 + hstepB, voffB); PG8_STAGE_A(PG8_SA(0, 0), a2, voffA);
            PG8_WAIT_V(8); PG8_WAIT_L(0); PG8_BAR; PG8_MMAB(1, 0, 1); PG8_BAR; PG8_SCHED;
            PG8_LDB(B0, 1, 0); PG8_LDB(B1, 1, 1); PG8_SCHED; PG8_LDA(At, 1, 0); PG8_STAGE_A(PG8_SA(0, 1), a2 + hstepA, voffA);
            PG8_WAIT_V(8); PG8_WAIT_L(0); PG8_BAR; PG8_MMAB(0, 1, 0); PG8_BAR; PG8_SCHED;
            PG8_LDA(At, 1, 1); PG8_STAGE_B(PG8_SB(1, 0), b3, voffB); PG8_STAGE_B(PG8_SB(1, 1), b3 + hstepB, voffB); PG8_STAGE_A(PG8_SA(1, 0), a3, voffA);
            PG8_WAIT_V(8); PG8_WAIT_L(0); PG8_BAR; PG8_MMAB(1, 1, 1); PG8_BAR; PG8_SCHED;
        }
        if constexpr (ALIGN_EPI) { if (wr == 0) PG8_BAR; }
        { const int l2 = lane_id(); E(acc, cur, wr, wc, l2 & 15, l2 >> 4); }
        if (!has_next) break;
#pragma unroll
        for (int a = 0; a < 2; ++a)
#pragma unroll
            for (int b = 0; b < 2; ++b)
#pragma unroll
                for (int m = 0; m < 4; ++m)
#pragma unroll
                    for (int n = 0; n < 2; ++n) acc[a][b][m][n] = (f32x4){0.f, 0.f, 0.f, 0.f};
        cur = nxt; cA = nA; cB = nB; ++ui;
        if constexpr (ALIGN_EPI) { if (wr == 1) PG8_BAR; }
    }
    PG8_WAIT_V(0);
    if constexpr (!ALIGN_EPI) { if (wr == 0) PG8_BAR; }
    PG8_BAR;
#undef PG8_SA
#undef PG8_SB
#undef PG8_STAGE_A
#undef PG8_STAGE_B
#undef PG8_LDA
#undef PG8_LDB
#undef PG8_MMA
#undef PG8_MMA8H
#undef PG8_MMAB
#undef PG8_LDA_HI
#undef PG8_WAIT_V
#undef PG8_WAIT_L
#undef PG8_BAR
#undef PG8_SCHED
#undef PG8_UA
#undef PG8_UB
}
}

#define XB_TMO      128
#define XB_XCNT(j)  (256  + 64 * (j))
#define XB_XSUB(j)  (1280 + 64 * (j))
#define XB_XGEN(j)  (2304 + 64 * (j))
#define XB_TOP      3328
#define XB_TOPGEN   3392
#define XCD_BAR_WORDS 3456
#define XB_SPIN_CAP (1u << 18)
__device__ __forceinline__ unsigned xb_ld(unsigned* p)              { return __hip_atomic_load(p, __ATOMIC_RELAXED, __HIP_MEMORY_SCOPE_AGENT); }
__device__ __forceinline__ unsigned xb_add(unsigned* p, unsigned v) { return __hip_atomic_fetch_add(p, v, __ATOMIC_RELAXED, __HIP_MEMORY_SCOPE_AGENT); }
__device__ __forceinline__ unsigned xb_xcc_id() { return (unsigned)__builtin_amdgcn_s_getreg((3 << 11) | 20) & 0xFu; }
#define XB_SPIN(cond, bar) do { unsigned _sp = 0; while (cond) { __builtin_amdgcn_s_sleep(1); \
    if ((++_sp & 255u) == 0u) { if (xb_ld(&(bar)[XB_TMO])) break; if (_sp > XB_SPIN_CAP) { atomicAdd(&(bar)[XB_TMO], 1u); break; } } } } while (0)
struct XcdBarrier { unsigned* bar; unsigned x; volatile LAS unsigned* st; };
__device__ __forceinline__ XcdBarrier xcd_barrier_post(unsigned* bar, volatile LAS unsigned* st) {
    XcdBarrier b; b.bar = bar; b.x = xb_xcc_id(); b.st = st;
    if (threadIdx.x == 0) (void)xb_add(&bar[XB_XCNT(b.x)], 1u);
    return b;
}
__device__ __forceinline__ void xcd_barrier_complete(unsigned* bar, unsigned x, unsigned& nloc, unsigned& nx) {
    const unsigned G = gridDim.x * gridDim.y * gridDim.z;
    unsigned sum, cnt, mine, sp = 0u;
    for (;;) {
        sum = 0u; cnt = 0u; mine = 0u;
#pragma unroll
        for (unsigned j = 0; j < 16; ++j) { const unsigned c = xb_ld(&bar[XB_XCNT(j)]); sum += c; cnt += (c > 0u) ? 1u : 0u; mine = (j == x) ? c : mine; }
        if (sum == G) break;
        __builtin_amdgcn_s_sleep(1);
        if ((++sp & 255u) == 0u) { if (xb_ld(&bar[XB_TMO])) break; if (sp > XB_SPIN_CAP) { atomicAdd(&bar[XB_TMO], 1u); break; } }
    }
    nloc = mine > 0u ? mine : 1u; nx = cnt > 0u ? cnt : 1u;
}
__device__ __forceinline__ void xcd_barrier(const XcdBarrier& b, const bool leader) {
    asm volatile("s_waitcnt vmcnt(0)" ::: "memory");
    __syncthreads();
    if (leader) {
        unsigned* bar = b.bar;
        __builtin_amdgcn_s_waitcnt(0);
        unsigned nloc = b.st[0], nx = b.st[1];
        if (nloc == 0u) { xcd_barrier_complete(bar, b.x, nloc, nx); b.st[0] = nloc; b.st[1] = nx; }
        const unsigned old = xb_add(&bar[XB_XSUB(b.x)], 1u);
        const unsigned gen = old / nloc;
        if (old + 1u == (gen + 1u) * nloc) {
            __builtin_amdgcn_fence(__ATOMIC_RELEASE, "agent");
            asm volatile("s_waitcnt vmcnt(0)" ::: "memory");
            const unsigned og = xb_add(&bar[XB_TOP], 1u);
            const unsigned tg = og / nx;
            if (og + 1u == (tg + 1u) * nx) xb_add(&bar[XB_TOPGEN], 1u);
            else XB_SPIN(xb_ld(&bar[XB_TOPGEN]) == tg, bar);
            __builtin_amdgcn_fence(__ATOMIC_ACQUIRE, "agent");
            xb_add(&bar[XB_XGEN(b.x)], 1u);
            asm volatile("s_waitcnt vmcnt(0)" ::: "memory");
        } else {
            XB_SPIN(xb_ld(&bar[XB_XGEN(b.x)]) == gen, bar);
            __builtin_amdgcn_fence(__ATOMIC_ACQUIRE, "agent");
            asm volatile("s_waitcnt vmcnt(0)" ::: "memory");
        }
    }
    __syncthreads();
}

constexpr int NWAVES = 8, NTHREADS = 512;
constexpr int RING_BYTES = 131072, LDSCTL_OFF = 139264, MISC_OFF = LDSCTL_OFF + 320, XCH_OFF = LDSCTL_OFF + 1024, LDS_BYTES = 147456;
constexpr int NPL = 12, N_PHASES = 1 + NPL * DEPTH;

struct Args { const float* in[17]; float* out; unsigned char* ws; int ph_lo, ph_hi; };
static_assert(sizeof(Args) == 17 * 8 + 8 + 8 + 8, "no padding");

struct Frame { LAS unsigned char* lds; int tid, lane, wave, G, gw, ngw; };
typedef __attribute__((address_space(4))) const unsigned char* kptr_t;
__device__ __forceinline__ kptr_t kbase() { kptr_t p = (kptr_t)__builtin_amdgcn_kernarg_segment_ptr(); asm volatile("" : "+s"(p)); return p; }
__device__ __forceinline__ const float* kin(int i) { return *(const float* const __attribute__((address_space(4)))*)(kbase() + 8 * i); }
__device__ __forceinline__ float* kout() { return *(float* const __attribute__((address_space(4)))*)(kbase() + 136); }
__device__ __forceinline__ unsigned char* kws() { return *(unsigned char* const __attribute__((address_space(4)))*)(kbase() + 144); }
__device__ __forceinline__ void refresh(Frame& F) { int t = F.wave * 64 + lane_id(); asm volatile("" : "+v"(t)); F.tid = t; F.lane = t & 63; F.gw = blockIdx.x * 8 + F.wave; }
enum { I_X = 0, I_META, I_NPM, I_NQM, I_NPF, I_NQF, I_WIN, I_BIF, I_GAIN, I_CMW, I_PW, I_PS, I_WBR, I_WOUT, I_WFFI, I_FCW, I_WFFO };

constexpr float W8_SCALE = 128.0f;
constexpr int WT_LD = 65, WT_BYTES = 64 * WT_LD * 4;
static_assert(8 * WT_BYTES <= LDSCTL_OFF, "weight tiles");
__device__ __forceinline__ void transpose_item64(const float* src, int ldw, unsigned char* dst, int ldb, bool f8, LAS float* scr, int lane) {
    const float* wp = src + lane;
    float v[64];
#pragma unroll
    for (int i = 0; i < 64; ++i) v[i] = __builtin_nontemporal_load(wp + (size_t)i * ldw);
#pragma unroll
    for (int i = 0; i < 64; ++i) scr[i * WT_LD + lane] = v[i];
    LDS_WAIT(); asm volatile("" ::: "memory");
    const int c = lane & 7;
#pragma unroll
    for (int j = 0; j < 8; ++j) { const int n = (lane >> 3) + 8 * j; const LAS float* s = scr + (8 * c) * WT_LD + n;
        if (!f8) { u32x4 o; o.x = pk2(s[0 * WT_LD], s[1 * WT_LD]); o.y = pk2(s[2 * WT_LD], s[3 * WT_LD]); o.z = pk2(s[4 * WT_LD], s[5 * WT_LD]); o.w = pk2(s[6 * WT_LD], s[7 * WT_LD]);
            *(u32x4*)(dst + (size_t)n * ldb + 16 * c) = o; }
        else { int p0 = 0, p1 = 0;
            p0 = __builtin_amdgcn_cvt_pk_fp8_f32(s[0 * WT_LD] * W8_SCALE, s[1 * WT_LD] * W8_SCALE, p0, false); p0 = __builtin_amdgcn_cvt_pk_fp8_f32(s[2 * WT_LD] * W8_SCALE, s[3 * WT_LD] * W8_SCALE, p0, true);
            p1 = __builtin_amdgcn_cvt_pk_fp8_f32(s[4 * WT_LD] * W8_SCALE, s[5 * WT_LD] * W8_SCALE, p1, false); p1 = __builtin_amdgcn_cvt_pk_fp8_f32(s[6 * WT_LD] * W8_SCALE, s[7 * WT_LD] * W8_SCALE, p1, true);
            u32x2 q; q.x = (unsigned)p0; q.y = (unsigned)p1; *(u32x2*)(dst + (size_t)n * ldb + 8 * c) = q; } }
    LDS_WAIT(); asm volatile("" ::: "memory");
}
__device__ __forceinline__ void weights_phase(Frame& F, int l) {
    LAS float* scr = (LAS float*)(F.lds + F.wave * WT_BYTES);
    unsigned char* ws = kws();
    bf16* Bt_in = (bf16*)(ws + WS_W + W_IN); bf16* Bt_br = (bf16*)(ws + WS_W + W_BR); bf16* Bt_out = (bf16*)(ws + WS_W + W_OUT); bf16* Bt_ffi = (bf16*)(ws + WS_W + W_FFI); bf16* Bt_ffo = (bf16*)(ws + WS_W + W_FFO);
    const float* w_in = kin(I_WIN) + (size_t)l * DM * INCOLS;
    const float* w_br = kin(I_WBR) + (size_t)l * 3 * MIXW * DM;
    const float* w_out = kin(I_WOUT) + (size_t)l * DM * DM;
    const float* w_ffi = kin(I_WFFI) + (size_t)l * DM * 2 * DFF;
    const float* w_ffo = kin(I_WFFO) + (size_t)l * DFF * DM;
    constexpr int G_IN = NIN / 64 + 1;
    constexpr int I_IN = G_IN * (DM / 64), I_BR = (DM / 64) * (3072 / 64), I_OUT = (DM / 64) * (DM / 64), I_FFI = (2 * DFF / 64) * (DM / 64), I_FFO = (DM / 64) * (DFF / 64);
    constexpr int NITEMS = I_IN + I_BR + I_OUT + I_FFI + I_FFO;
    for (int it = F.gw; it < NITEMS; it += F.ngw) {
        int r = it;
        if (r < I_IN) { const int kb = r / G_IN, nb = r % G_IN; const int drow = nb * 64, k0 = kb * 64;
            if (drow >= ZPU && drow < ZG) continue;
            const int scol = drow < 4096 ? drow : (drow < NIN ? drow + 16 : 4096);
            if (drow >= ZG && drow < NIN) { transpose_item64(w_in + (size_t)k0 * INCOLS + scol, INCOLS, (unsigned char*)(Bt_in + (size_t)ZG * DM) + (size_t)(drow - ZG) * DM + k0, DM, true, scr, F.lane); continue; }
            transpose_item64(w_in + (size_t)k0 * INCOLS + scol, INCOLS, (unsigned char*)Bt_in + ((size_t)drow * DM + k0) * 2, DM * 2, false, scr, F.lane); continue; } r -= I_IN;
        if (r < I_BR) { const int nblk = DM / 64, kb = r / nblk, nb = r % nblk; transpose_item64(w_br + (size_t)kb * 64 * DM + nb * 64, DM, (unsigned char*)Bt_br + ((size_t)nb * 64 * 3072 + kb * 64) * 2, 3072 * 2, false, scr, F.lane); continue; } r -= I_BR;
        if (r < I_OUT) { const int nblk = DM / 64, kb = r / nblk, nb = r % nblk; transpose_item64(w_out + (size_t)kb * 64 * DM + nb * 64, DM, (unsigned char*)Bt_out + ((size_t)nb * 64 * DM + kb * 64) * 2, DM * 2, false, scr, F.lane); continue; } r -= I_OUT;
        if (r < I_FFI) { const int nblk = 2 * DFF / 64, kb = r / nblk, nb = r % nblk; const int drow = nb * 64, tile = drow >> 8, wq = drow & 255;
            const int scol = wq < 128 ? tile * 128 + wq : DFF + tile * 128 + (wq - 128);
            transpose_item64(w_ffi + (size_t)kb * 64 * 2 * DFF + scol, 2 * DFF, (unsigned char*)Bt_ffi + ((size_t)drow * DM + kb * 64) * 2, DM * 2, false, scr, F.lane); continue; } r -= I_FFI;
        { const int nblk = DM / 64, kb = r / nblk, nb = r % nblk; transpose_item64(w_ffo + (size_t)kb * 64 * DM + nb * 64, DM, (unsigned char*)Bt_ffo + ((size_t)nb * 64 * DFF + kb * 64) * 2, DFF * 2, false, scr, F.lane); }
    }
    __syncthreads();
    const float* pw = kin(I_PW) + (size_t)l * 4 * 256 * 256; const float* ps = kin(I_PS) + (size_t)l * MIXW;
    LAS float* tile = (LAS float*)F.lds;
    for (int it = blockIdx.x; it < 4 * (DM / 32); it += F.G) {
        const int g = it & 3, k0 = (it >> 2) * 32;
        for (int e = F.tid; e < 32 * 256; e += NTHREADS) { const int kk = e >> 8, j = e & 255; tile[e] = w_in[(size_t)(k0 + kk) * INCOLS + 7184 + g * 256 + j]; }
        __syncthreads();
        const int c = F.tid & 255, kh = F.tid >> 8;
        float acc[16];
#pragma unroll
        for (int i = 0; i < 16; ++i) acc[i] = 0.f;
        for (int j = 0; j < 256; j += 4) { const float* pp = pw + ((size_t)g * 256 + j) * 256 + c; const float wa = pp[0], wb = pp[256], wc_ = pp[512], wd = pp[768];
#pragma unroll
            for (int i = 0; i < 16; ++i) { const f32x4 t = *(const LAS f32x4*)(tile + (kh * 16 + i) * 256 + j); acc[i] += (t[0] * wa + t[1] * wb) + (t[2] * wc_ + t[3] * wd); } }
        const float sc = ps[g * 256 + c];
        u32x4 o0, o1;
        o0.x = pk2(acc[0] * sc, acc[1] * sc); o0.y = pk2(acc[2] * sc, acc[3] * sc); o0.z = pk2(acc[4] * sc, acc[5] * sc); o0.w = pk2(acc[6] * sc, acc[7] * sc);
        o1.x = pk2(acc[8] * sc, acc[9] * sc); o1.y = pk2(acc[10] * sc, acc[11] * sc); o1.z = pk2(acc[12] * sc, acc[13] * sc); o1.w = pk2(acc[14] * sc, acc[15] * sc);
        bf16* dst = Bt_in + (size_t)(ZPU + g * 256 + c) * DM + k0 + kh * 16;
        *(u32x4*)dst = o0; *(u32x4*)(dst + 8) = o1;
        __syncthreads();
    }
}

__device__ __forceinline__ void store_h_row(bf16* hrow, unsigned char* h8row, const f32x4 (&v)[8], float r, const float* g, int lane) {
#pragma unroll
    for (int j = 0; j < 4; ++j) { const f32x4 ga = *(const f32x4*)(g + 8 * lane + 512 * j), gb = *(const f32x4*)(g + 8 * lane + 512 * j + 4);
        const f32x4 a = v[2 * j] * r * ga, b = v[2 * j + 1] * r * gb;
        u32x4 w; w.x = pk2(a[0], a[1]); w.y = pk2(a[2], a[3]); w.z = pk2(b[0], b[1]); w.w = pk2(b[2], b[3]);
        *(u32x4*)(hrow + 8 * lane + 512 * j) = w;
        if (h8row) { int p0 = 0, p1 = 0;
            p0 = __builtin_amdgcn_cvt_pk_fp8_f32(a[0], a[1], p0, false); p0 = __builtin_amdgcn_cvt_pk_fp8_f32(a[2], a[3], p0, true);
            p1 = __builtin_amdgcn_cvt_pk_fp8_f32(b[0], b[1], p1, false); p1 = __builtin_amdgcn_cvt_pk_fp8_f32(b[2], b[3], p1, true);
            u32x2 q; q.x = (unsigned)p0; q.y = (unsigned)p1; *(u32x2*)(h8row + 8 * lane + 512 * j) = q; } }
}
__device__ __forceinline__ float sumsq8(const f32x4 (&v)[8]) { float s = 0.f;
#pragma unroll
    for (int j = 0; j < 8; ++j) s += (v[j][0] * v[j][0] + v[j][1] * v[j][1]) + (v[j][2] * v[j][2] + v[j][3] * v[j][3]);
    return s; }
__device__ __forceinline__ void norm0_phase(Frame& F) {
    const float* x = kin(I_X); const float* meta = kin(I_META); const float* g = kin(I_NPM); unsigned char* ws = kws(); bf16* H = (bf16*)(ws + WS_H); unsigned char* H8 = ws + WS_H8;
    for (int row = F.gw; row < MT; row += F.ngw) {
        const float* xr = row < MR ? x + (size_t)row * DM : meta + (size_t)(row - MR) * DM;
        f32x4 v[8];
#pragma unroll
        for (int j = 0; j < 4; ++j) { v[2 * j] = *(const f32x4*)(xr + 8 * F.lane + 512 * j); v[2 * j + 1] = *(const f32x4*)(xr + 8 * F.lane + 512 * j + 4); }
        const float r = rsqrtf(wave_sum(sumsq8(v)) * (1.0f / DM) + RMS_EPS);
        store_h_row(H + (size_t)row * DM, H8 + (size_t)row * DM, v, r, g, F.lane);
    }
}
__device__ __forceinline__ void nrn_phase(Frame& F, const bf16* Y, const void* xin_real, bool in_bf16, const float* xin_meta, void* xout_real, bool out_bf16,
                                          const float* g_post, const float* g_next, bool want_h8) {
    unsigned char* ws = kws(); float* XM = (float*)(ws + WS_XM); bf16* H = (bf16*)(ws + WS_H); unsigned char* H8 = ws + WS_H8;
    for (int row = F.gw; row < MT; row += F.ngw) {
        const bf16* yr = Y + (size_t)row * DM;
        f32x4 y[8], x[8];
#pragma unroll
        for (int j = 0; j < 4; ++j) { const u32x4 w = *(const u32x4*)(yr + 8 * F.lane + 512 * j);
            y[2 * j] = (f32x4){bflo(w.x), bfhi(w.x), bflo(w.y), bfhi(w.y)}; y[2 * j + 1] = (f32x4){bflo(w.z), bfhi(w.z), bflo(w.w), bfhi(w.w)}; }
        if (row < MR && in_bf16) { const bf16* xr = (const bf16*)xin_real + (size_t)row * DM;
#pragma unroll
            for (int j = 0; j < 4; ++j) { const u32x4 w = *(const u32x4*)(xr + 8 * F.lane + 512 * j);
                x[2 * j] = (f32x4){bflo(w.x), bfhi(w.x), bflo(w.y), bfhi(w.y)}; x[2 * j + 1] = (f32x4){bflo(w.z), bfhi(w.z), bflo(w.w), bfhi(w.w)}; } }
        else { const float* xr = row < MR ? (const float*)xin_real + (size_t)row * DM : xin_meta + (size_t)(row - MR) * DM;
#pragma unroll
            for (int j = 0; j < 4; ++j) { x[2 * j] = *(const f32x4*)(xr + 8 * F.lane + 512 * j); x[2 * j + 1] = *(const f32x4*)(xr + 8 * F.lane + 512 * j + 4); } }
        const float r = rsqrtf(wave_sum(sumsq8(y)) * (1.0f / DM) + RMS_EPS);
#pragma unroll
        for (int j = 0; j < 4; ++j) { const f32x4 ga = *(const f32x4*)(g_post + 8 * F.lane + 512 * j), gb = *(const f32x4*)(g_post + 8 * F.lane + 512 * j + 4);
            x[2 * j] = x[2 * j] + y[2 * j] * r * ga; x[2 * j + 1] = x[2 * j + 1] + y[2 * j + 1] * r * gb; }
        if (row < MR && out_bf16) { bf16* xo = (bf16*)xout_real + (size_t)row * DM;
#pragma unroll
            for (int j = 0; j < 4; ++j) { u32x4 w; w.x = pk2(x[2 * j][0], x[2 * j][1]); w.y = pk2(x[2 * j][2], x[2 * j][3]); w.z = pk2(x[2 * j + 1][0], x[2 * j + 1][1]); w.w = pk2(x[2 * j + 1][2], x[2 * j + 1][3]);
                *(u32x4*)(xo + 8 * F.lane + 512 * j) = w; } }
        else { float* xo = row < MR ? (float*)xout_real + (size_t)row * DM : XM + (size_t)(row - MR) * DM;
#pragma unroll
            for (int j = 0; j < 4; ++j) { *(f32x4*)(xo + 8 * F.lane + 512 * j) = x[2 * j]; *(f32x4*)(xo + 8 * F.lane + 512 * j + 4) = x[2 * j + 1]; } }
        if (g_next) { const float r2 = rsqrtf(wave_sum(sumsq8(x)) * (1.0f / DM) + RMS_EPS); store_h_row(H + (size_t)row * DM, want_h8 ? H8 + (size_t)row * DM : (unsigned char*)nullptr, x, r2, g_next, F.lane); }
    }
}

__device__ __forceinline__ f32x4 thin_tile(const bf16* A, int lda, const bf16* Bt, int ldb, int K, int lane) {
    const bf16* ap = A + (size_t)(lane & 15) * lda + 8 * (lane >> 4);
    const bf16* bp = Bt + (size_t)(lane & 15) * ldb + 8 * (lane >> 4);
    f32x4 acc = {0.f, 0.f, 0.f, 0.f};
#pragma unroll 8
    for (int k = 0; k < K; k += 32) { const bf16x8 a = *(const bf16x8*)(ap + k); const bf16x8 b = *(const bf16x8*)(bp + k); acc = __builtin_amdgcn_mfma_f32_16x16x32_bf16(a, b, acc, 0, 0, 0); }
    return acc;
}

__device__ __forceinline__ f32x4 thin_part(const bf16* A, int lda, const bf16* Bt, int ldb, int k0, int klen, int lane) {
    const bf16* ap = A + (size_t)(lane & 15) * lda + 8 * (lane >> 4) + k0;
    const bf16* bp = Bt + (size_t)(lane & 15) * ldb + 8 * (lane >> 4) + k0;
    f32x4 acc = {0.f, 0.f, 0.f, 0.f};
#pragma unroll 16
    for (int k = 0; k < klen; k += 32) { const bf16x8 a = *(const bf16x8*)(ap + k); const bf16x8 b = *(const bf16x8*)(bp + k); acc = __builtin_amdgcn_mfma_f32_16x16x32_bf16(a, b, acc, 0, 0, 0); }
    return acc;
}
__device__ __forceinline__ f32x4 thin_part8(const unsigned char* A8, int lda, const unsigned char* B8, int ldb, int k0, int klen, int lane) {
    const unsigned char* ap = A8 + (size_t)(lane & 15) * lda + 32 * (lane >> 4) + k0;
    const unsigned char* bp = B8 + (size_t)(lane & 15) * ldb + 32 * (lane >> 4) + k0;
    f32x4 acc = {0.f, 0.f, 0.f, 0.f};
#pragma unroll 8
    for (int k = 0; k < klen; k += 128) { const pg8::v8i32 a = *(const pg8::v8i32*)(ap + k); const pg8::v8i32 b = *(const pg8::v8i32*)(bp + k);
        acc = __builtin_amdgcn_mfma_scale_f32_16x16x128_f8f6f4(a, b, acc, 0, 0, 0, 0x7f7f7f7f, 0, 0x7f7f7f7f); }
    return acc;
}
template <int NC, int KS, class Part, class Epi>
__device__ __forceinline__ void thin_wg(Frame& F, int ntiles, LAS f32x4* red, const Part& part, const Epi& epi) {
    static_assert(NC * KS == 8, "8 waves");
    const int sub = F.wave / KS, ks = F.wave % KS;
    for (int it = blockIdx.x; it * NC < ntiles; it += F.G) {
        const int ti = it * NC + sub;
        f32x4 acc = {0.f, 0.f, 0.f, 0.f};
        if (ti < ntiles) acc = part(ti, ks);
        red[F.wave * 64 + F.lane] = acc;
        __syncthreads();
        if (ks == 0 && ti < ntiles) {
#pragma unroll
            for (int j = 1; j < KS; ++j) acc += red[(F.wave + j) * 64 + F.lane];
            epi(ti, acc);
        }
        __syncthreads();
    }
}

typedef short s16x4 __attribute__((ext_vector_type(4)));
typedef short v4i16_t __attribute__((ext_vector_type(4)));
constexpr int DVE = 144, KS_RS = 272, VS_RS = 304, PM_RS = 144, RING_BYTES_C = 131072;
constexpr int NUNIT = 8 + NB * NHEAD * 64;
constexpr int USLOT = DVE * DHEAD;
constexpr size_t WS_SC = WS_IF + 1536 * 1024;
constexpr size_t WS_MC = WS_IF + 1792 * 1024;
static_assert((size_t)MT * 16 * 4 <= 1536 * 1024 && (size_t)NUNIT * USLOT * 2 <= 80 * MiB, "mlstm scratch");
__device__ __forceinline__ s16x4 tr16(const LAS unsigned char* p) { return __builtin_bit_cast(s16x4, __builtin_amdgcn_ds_read_tr16_b64_v4i16((LAS v4i16_t*)p)); }
__device__ __forceinline__ bf16x8 tr_frag(const LAS unsigned char* img, int RS, int ks, int c0, int lane) {
    const int g = lane >> 4, q = (lane & 15) >> 2, p = lane & 3;
    const LAS unsigned char* a = img + (32 * ks + 8 * g + q) * RS + c0 * 2 + 8 * p;
    const s16x4 lo = tr16(a), hi = tr16(a + 4 * RS);
    return __builtin_shufflevector(lo, hi, 0, 1, 2, 3, 4, 5, 6, 7);
}
__device__ __forceinline__ void unpack8(const u32x4 w, float (&f)[8]) { f[0] = bflo(w.x); f[1] = bfhi(w.x); f[2] = bflo(w.y); f[3] = bfhi(w.y); f[4] = bflo(w.z); f[5] = bfhi(w.z); f[6] = bflo(w.w); f[7] = bfhi(w.w); }
__device__ __forceinline__ u32x4 pack8(const float (&f)[8]) { u32x4 w; w.x = pk2(f[0], f[1]); w.y = pk2(f[2], f[3]); w.z = pk2(f[4], f[5]); w.w = pk2(f[6], f[7]); return w; }
__device__ __forceinline__ float logsigmoidf_(float x) {
    const float e = __builtin_amdgcn_exp2f(-1.4426950408889634f * fabsf(x));
    return fminf(x, 0.f) - 0.6931471805599453f * __builtin_amdgcn_logf(1.0f + e);
}
#define DPPX(oldv, srcv, CTRL, RM) __builtin_bit_cast(float, __builtin_amdgcn_update_dpp(__builtin_bit_cast(int, (float)(oldv)), __builtin_bit_cast(int, (float)(srcv)), (CTRL), (RM), 0xf, false))
__device__ __forceinline__ float wave_scan_add(float x, int) {
    x += DPPX(0.f, x, 0x111, 0xf); x += DPPX(0.f, x, 0x112, 0xf); x += DPPX(0.f, x, 0x114, 0xf); x += DPPX(0.f, x, 0x118, 0xf);
    x += DPPX(0.f, x, 0x142, 0xa); x += DPPX(0.f, x, 0x143, 0xc);
    return x;
}
__device__ __forceinline__ float wave_scan_max(float x, int) {
    const float ninf = -INFINITY;
    x = fmaxf(x, DPPX(ninf, x, 0x111, 0xf)); x = fmaxf(x, DPPX(ninf, x, 0x112, 0xf)); x = fmaxf(x, DPPX(ninf, x, 0x114, 0xf)); x = fmaxf(x, DPPX(ninf, x, 0x118, 0xf));
    x = fmaxf(x, DPPX(ninf, x, 0x142, 0xa)); x = fmaxf(x, DPPX(ninf, x, 0x143, 0xc));
    return x;
}
__device__ __forceinline__ void unit_decode(int u, int& b, int& h, int& T, int& row0, int& bh, int& c) {
    if (u < 8) { b = 0; h = u; T = NMETA; row0 = MR; bh = u; c = 0; }
    else { const int v = u - 8; const int c1 = v & 63; bh = v >> 6; h = bh & 7; b = bh >> 3; T = 64; row0 = b * SEQ + c1 * 64; c = c1 + 1; }
}
__device__ __forceinline__ void mlstm_u_phase(Frame& F, int l) {
    unsigned char* ws = kws(); const bf16* Z = (const bf16*)(ws + WS_Z); const float* IFb = (const float*)(ws + WS_IF); const float* b_if = kin(I_BIF);
    bf16* U = (bf16*)(ws + WS_MIX); float* SC = (float*)(ws + WS_SC);
    LAS unsigned char* ksm = F.lds; LAS unsigned char* vsm = F.lds + 64 * KS_RS;
    const int tid = F.tid, lane = F.lane, wave = F.wave;
    for (int u = blockIdx.x; u < NUNIT; u += F.G) {
        int b, h, T, row0, bh, c; unit_decode(u, b, h, T, row0, bh, c);
        const float bi = b_if[(l * 2 + 0) * NHEAD + h], bfv = b_if[(l * 2 + 1) * NHEAD + h];
        float li = 0.f, lfv = 0.f;
        if (lane < T) { li = IFb[(size_t)(row0 + lane) * 16 + h] + bi; lfv = logsigmoidf_(IFb[(size_t)(row0 + lane) * 16 + 8 + h] + bfv); }
        const float bcum = wave_scan_add(lfv, lane);
        const float a = lane < T ? li - bcum : -INFINITY;
        const float amax = __builtin_bit_cast(float, __builtin_amdgcn_readlane(__builtin_bit_cast(int, wave_scan_max(a, lane)), 63));
        const float bT = __builtin_bit_cast(float, __builtin_amdgcn_readlane(__builtin_bit_cast(int, bcum), 63));
        const float wsl = lane < T ? expf(a - amax) : 0.f;
        if (tid == 0) { SC[2 * u] = bT; SC[2 * u + 1] = amax; }
#pragma unroll
        for (int pi = 0; pi < 2; ++pi) {
            const int p = tid + NTHREADS * pi, s = p >> 4, d8 = (p & 15) * 8;
            float wv;
            { const int sb = 4 * wave + 32 * pi; const int wi = __builtin_bit_cast(int, wsl);
              const float r0 = __builtin_bit_cast(float, __builtin_amdgcn_readlane(wi, sb)), r1 = __builtin_bit_cast(float, __builtin_amdgcn_readlane(wi, sb + 1)),
                          r2 = __builtin_bit_cast(float, __builtin_amdgcn_readlane(wi, sb + 2)), r3 = __builtin_bit_cast(float, __builtin_amdgcn_readlane(wi, sb + 3));
              const int k = lane >> 4; wv = k == 0 ? r0 : (k == 1 ? r1 : (k == 2 ? r2 : r3)); }
            u32x4 kv = {0u, 0u, 0u, 0u}, vv = {0u, 0u, 0u, 0u};
            if (s < T) { const bf16* zr = Z + (size_t)(row0 + s) * ZP + h * DHEAD + d8; kv = *(const u32x4*)(zr + ZK); vv = *(const u32x4*)(zr + ZV); }
            *(LAS u32x4*)(ksm + s * KS_RS + d8 * 2) = kv;
            u32x4 sv; sv.x = pk2(bflo(vv.x) * wv, bfhi(vv.x) * wv); sv.y = pk2(bflo(vv.y) * wv, bfhi(vv.y) * wv); sv.z = pk2(bflo(vv.z) * wv, bfhi(vv.z) * wv); sv.w = pk2(bflo(vv.w) * wv, bfhi(vv.w) * wv);
            *(LAS u32x4*)(vsm + s * VS_RS + d8 * 2) = sv;
        }
        if (tid < 64) { const u32x4 o = {f2bf(wsl), 0u, 0u, 0u}; unsigned zz_; asm volatile("v_mov_b32 %0, 0" : "=v"(zz_)); const u32x4 z = {zz_, zz_, zz_, zz_};
            *(LAS u32x4*)(vsm + tid * VS_RS + 256) = o; *(LAS u32x4*)(vsm + tid * VS_RS + 272) = z; }
        __syncthreads();
        const bf16x8 A0 = tr_frag(ksm, KS_RS, 0, 16 * wave, lane), A1 = tr_frag(ksm, KS_RS, 1, 16 * wave, lane);
        bf16* Uu = U + (size_t)u * USLOT;
#pragma unroll
        for (int j = 0; j < 9; ++j) {
            const bf16x8 B0 = tr_frag(vsm, VS_RS, 0, 16 * j, lane), B1 = tr_frag(vsm, VS_RS, 1, 16 * j, lane);
            f32x4 acc = {0.f, 0.f, 0.f, 0.f};
            acc = __builtin_amdgcn_mfma_f32_16x16x32_bf16(A0, B0, acc, 0, 0, 0);
            acc = __builtin_amdgcn_mfma_f32_16x16x32_bf16(A1, B1, acc, 0, 0, 0);
            u32x2 o; o.x = pk2(acc[0], acc[1]); o.y = pk2(acc[2], acc[3]);
            *(u32x2*)(Uu + (16 * j + (lane & 15)) * DHEAD + 16 * wave + 4 * (lane >> 4)) = o;
        }
        __syncthreads();
    }
}
__device__ __forceinline__ void mlstm_scan_phase(Frame& F) {
    unsigned char* ws = kws(); bf16* U = (bf16*)(ws + WS_MIX); const float* SC = (const float*)(ws + WS_SC); float* MC = (float*)(ws + WS_MC);
    constexpr int OPS = USLOT / 8;
    for (int q = blockIdx.x * NTHREADS + F.tid; q < 32 * OPS; q += F.G * NTHREADS) {
        const int bh = q / OPS, idx = q - bh * OPS, h = bh & 7;
        float st[8], m = 0.f;
#pragma unroll
        for (int j = 0; j < 8; ++j) st[j] = 0.f;
        {
            float uf[8]; unpack8(*(const u32x4*)(U + (size_t)h * USLOT + idx * 8), uf); const float bT = SC[2 * h], amax = SC[2 * h + 1];
            if (idx == 0) MC[bh * 65] = 0.f;
            const float m1 = bT + fmaxf(m, amax), dec = expf(bT + m - m1), wu = expf(bT + amax - m1);
#pragma unroll
            for (int j = 0; j < 8; ++j) st[j] = dec * st[j] + wu * uf[j];
            m = m1;
        }
        for (int c0 = 0; c0 < 64; c0 += 16) {
            u32x4 uq[16]; float bT[16], am[16];
#pragma unroll
            for (int i = 0; i < 16; ++i) { const int unit = 8 + bh * 64 + c0 + i; uq[i] = *(const u32x4*)(U + (size_t)unit * USLOT + idx * 8); bT[i] = SC[2 * unit]; am[i] = SC[2 * unit + 1]; }
#pragma unroll
            for (int i = 0; i < 16; ++i) { const int unit = 8 + bh * 64 + c0 + i;
                *(u32x4*)(U + (size_t)unit * USLOT + idx * 8) = pack8(st);
                if (idx == 0) MC[bh * 65 + c0 + i + 1] = m;
                float uf[8]; unpack8(uq[i], uf);
                const float m1 = bT[i] + fmaxf(m, am[i]), dec = expf(bT[i] + m - m1), wu = expf(bT[i] + am[i] - m1);
#pragma unroll
                for (int j = 0; j < 8; ++j) st[j] = dec * st[j] + wu * uf[j];
                m = m1; }
        }
    }
}
#define BAR_LDS() do { asm volatile("s_waitcnt lgkmcnt(0)" ::: "memory"); __builtin_amdgcn_s_barrier(); asm volatile("" ::: "memory"); } while (0)
constexpr int KQ_RS = 272, OL_K = 0, OL_Q = 64 * KQ_RS, OL_C = 2 * 64 * KQ_RS, OL_V = OL_C + DVE * KQ_RS, OL_P = OL_V + 64 * VS_RS, OL_T = OL_P + 64 * PM_RS;
static_assert(OL_T + 8 * 256 <= RING_BYTES_C, "mlstm out LDS");
struct OutRegs { u32x4 pk[2], pq[2], pv[2], pc[5]; float li, xf, mc; };
__device__ __forceinline__ void out_issue(OutRegs& R, int u, int l, const bf16* Z, const float* IFb, const bf16* U, const float* MC, int tid, int lane, int wave) {
    int b, h, T, row0, bh, c; unit_decode(u, b, h, T, row0, bh, c);
    R.mc = u >= 8 ? MC[bh * 65 + c] : 0.f; R.li = 0.f; R.xf = 0.f;
    if (wave == 0 && lane < T) { R.li = IFb[(size_t)(row0 + lane) * 16 + h]; R.xf = IFb[(size_t)(row0 + lane) * 16 + 8 + h]; }
#pragma unroll
    for (int pi = 0; pi < 2; ++pi) { const int p = tid + NTHREADS * pi, s = p >> 4, d8 = (p & 15) * 8;
        R.pk[pi] = (u32x4){0u, 0u, 0u, 0u}; R.pq[pi] = R.pk[pi]; R.pv[pi] = R.pk[pi];
        if (s < T) { const bf16* zr = Z + (size_t)(row0 + s) * ZP + h * DHEAD + d8; R.pk[pi] = *(const u32x4*)(zr + ZK); R.pq[pi] = *(const u32x4*)(zr + ZQ); R.pv[pi] = *(const u32x4*)(zr + ZV); } }
    const bf16* Ct = U + (size_t)u * USLOT;
#pragma unroll
    for (int pi = 0; pi < 5; ++pi) { const int p = tid + NTHREADS * pi; R.pc[pi] = (u32x4){0u, 0u, 0u, 0u}; if (u >= 8 && p < DVE * 16) R.pc[pi] = *(const u32x4*)(Ct + p * 8); }
}
__device__ __forceinline__ void mlstm_out_phase(Frame& F, int l) {
    unsigned char* ws = kws(); const bf16* Z = (const bf16*)(ws + WS_Z); const float* IFb = (const float*)(ws + WS_IF); const float* b_if = kin(I_BIF);
    const bf16* U = (const bf16*)(ws + WS_MIX); const float* MC = (const float*)(ws + WS_MC); bf16* YS = (bf16*)(ws + WS_YS);
    const float* gain = kin(I_GAIN) + (size_t)l * MIXW;
    LAS unsigned char* ksm = F.lds + OL_K; LAS unsigned char* qsm = F.lds + OL_Q; LAS unsigned char* csm = F.lds + OL_C; LAS unsigned char* vsm = F.lds + OL_V; LAS unsigned char* Pm = F.lds + OL_P;
    LAS float* Atab = (LAS float*)(F.lds + OL_T); LAS float* MM = Atab + 64, *IWQ = MM + 64, *EM = IWQ + 64, *DEN = EM + 64, *SS = DEN + 64;
    const int tid = F.tid, lane = F.lane, wave = F.wave;
    const float qscale = 0.08838834764831845f;
    const int tt = wave & 3, js = wave >> 2, g = lane >> 4;
    OutRegs R;
    if ((int)blockIdx.x < NUNIT) out_issue(R, blockIdx.x, l, Z, IFb, U, MC, tid, lane, wave);
    for (int u = blockIdx.x; u < NUNIT; u += F.G) {
        int b, h, T, row0, bh, c; unit_decode(u, b, h, T, row0, bh, c);
        const bool has_state = u >= 8;
        const bool tvalid = 16 * tt < T;
        const int trow = 16 * tt + (lane & 15);
        if (wave == 0) {
            const float bi = b_if[(l * 2 + 0) * NHEAD + h], bfv = b_if[(l * 2 + 1) * NHEAD + h];
            const float lfv = lane < T ? logsigmoidf_(R.xf + bfv) : 0.f;
            const float bcum = wave_scan_add(lfv, lane);
            const float a = lane < T ? R.li + bi - bcum : -INFINITY;
            const float pm = wave_scan_max(a, lane);
            const float mm = fmaxf(R.mc, pm);
            Atab[lane] = a; MM[lane] = mm; IWQ[lane] = expf(R.mc - mm) * qscale; EM[lane] = expf(-(bcum + mm));
        }
#pragma unroll
        for (int pi = 0; pi < 2; ++pi) { const int p = tid + NTHREADS * pi, s = p >> 4, ch = p & 15;
            *(LAS u32x4*)(ksm + s * KQ_RS + ch * 16) = R.pk[pi]; *(LAS u32x4*)(qsm + s * KQ_RS + ch * 16) = R.pq[pi]; *(LAS u32x4*)(vsm + s * VS_RS + ch * 16) = R.pv[pi]; }
#pragma unroll
        for (int pi = 0; pi < 5; ++pi) { const int p = tid + NTHREADS * pi; if (p < DVE * 16) *(LAS u32x4*)(csm + (p >> 4) * KQ_RS + (p & 15) * 16) = R.pc[pi]; }
        if (tid < 64) { const u32x4 o = {tid < T ? 0x3f80u : 0u, 0u, 0u, 0u}; unsigned zz_; asm volatile("v_mov_b32 %0, 0" : "=v"(zz_)); const u32x4 z = {zz_, zz_, zz_, zz_};
            *(LAS u32x4*)(vsm + tid * VS_RS + 256) = o; *(LAS u32x4*)(vsm + tid * VS_RS + 272) = z; }
        BAR_LDS();
        if (u + F.G < NUNIT) out_issue(R, u + F.G, l, Z, IFb, U, MC, tid, lane, wave);
        u32x2 og[5];
#pragma unroll
        for (int jj = 0; jj < 5; ++jj) { const int j = js + 2 * jj; og[jj] = (u32x2){0u, 0u};
            if (tvalid && j < 8) og[jj] = *(const u32x2*)(Z + (size_t)(row0 + trow) * ZP + ZO + h * DHEAD + 16 * j + 4 * g); }
        bf16x8 Q[4];
#pragma unroll
        for (int ks = 0; ks < 4; ++ks) Q[ks] = *(const LAS bf16x8*)(qsm + trow * KQ_RS + 64 * ks + 16 * g);
#pragma unroll
        for (int i = 0; i < 2; ++i) {
            const int ts = 2 * js + i;
            u32x2 outp = {0u, 0u};
            if (tvalid && ts <= tt) {
                f32x4 acc = {0.f, 0.f, 0.f, 0.f};
#pragma unroll
                for (int ks = 0; ks < 4; ++ks) { const bf16x8 Ak = *(const LAS bf16x8*)(ksm + (16 * ts + (lane & 15)) * KQ_RS + 64 * ks + 16 * g); acc = __builtin_amdgcn_mfma_f32_16x16x32_bf16(Ak, Q[ks], acc, 0, 0, 0); }
                const float mmt = MM[trow];
                float pv[4];
#pragma unroll
                for (int i2 = 0; i2 < 4; ++i2) { const int s = 16 * ts + 4 * g + i2; pv[i2] = s <= trow ? acc[i2] * qscale * expf(Atab[s] - mmt) : 0.f; }
                outp.x = pk2(pv[0], pv[1]); outp.y = pk2(pv[2], pv[3]);
            }
            *(LAS u32x2*)(Pm + trow * PM_RS + (16 * ts + 4 * g) * 2) = outp;
        }
        BAR_LDS();
        f32x4 accs[5];
#pragma unroll
        for (int jj = 0; jj < 5; ++jj) accs[jj] = (f32x4){0.f, 0.f, 0.f, 0.f};
        if (tvalid) {
            const bf16x8 PB0 = *(const LAS bf16x8*)(Pm + trow * PM_RS + (8 * g) * 2), PB1 = *(const LAS bf16x8*)(Pm + trow * PM_RS + (32 + 8 * g) * 2);
            const float iwq = IWQ[trow];
#pragma unroll
            for (int jj = 0; jj < 5; ++jj) {
                const int j = js + 2 * jj;
                if (j <= 8) {
                    f32x4 acc = {0.f, 0.f, 0.f, 0.f};
                    if (has_state) {
#pragma unroll
                        for (int ks = 0; ks < 4; ++ks) { const bf16x8 Ac = *(const LAS bf16x8*)(csm + (16 * j + (lane & 15)) * KQ_RS + 64 * ks + 16 * g); acc = __builtin_amdgcn_mfma_f32_16x16x32_bf16(Ac, Q[ks], acc, 0, 0, 0); }
                        acc = acc * iwq;
                    }
                    { const bf16x8 Av = tr_frag(vsm, VS_RS, 0, 16 * j, lane); acc = __builtin_amdgcn_mfma_f32_16x16x32_bf16(Av, PB0, acc, 0, 0, 0); }
                    if (tt >= 2) { const bf16x8 Av = tr_frag(vsm, VS_RS, 1, 16 * j, lane); acc = __builtin_amdgcn_mfma_f32_16x16x32_bf16(Av, PB1, acc, 0, 0, 0); }
                    accs[jj] = acc;
                    if (j == 8 && g == 0) DEN[trow] = acc[0];
                }
            }
        }
        BAR_LDS();
        if (tvalid) {
            const float den = DEN[trow]; const float inv = 1.0f / fmaxf(fabsf(den), EM[trow]);
            float ssp = 0.f;
#pragma unroll
            for (int jj = 0; jj < 5; ++jj) { const int j = js + 2 * jj; if (j < 8) { accs[jj] = accs[jj] * inv; ssp += (accs[jj][0] * accs[jj][0] + accs[jj][1] * accs[jj][1]) + (accs[jj][2] * accs[jj][2] + accs[jj][3] * accs[jj][3]); } }
            ssp += __shfl_xor(ssp, 16); ssp += __shfl_xor(ssp, 32);
            if (g == 0) SS[js * 64 + trow] = ssp;
        }
        BAR_LDS();
        if (tvalid) {
            const float r = rsqrtf((SS[trow] + SS[64 + trow]) * (1.0f / DHEAD) + RMS_EPS);
            bf16* yr = YS + (size_t)(row0 + trow) * 3072 + h * DHEAD + 4 * g;
#pragma unroll
            for (int jj = 0; jj < 5; ++jj) { const int j = js + 2 * jj;
                if (j < 8) { const f32x4 gn = *(const f32x4*)(gain + h * DHEAD + 16 * j + 4 * g);
                    const float y0 = accs[jj][0] * r * gn[0] * sigmoidf_(bflo(og[jj].x)), y1 = accs[jj][1] * r * gn[1] * sigmoidf_(bfhi(og[jj].x));
                    const float y2 = accs[jj][2] * r * gn[2] * sigmoidf_(bflo(og[jj].y)), y3 = accs[jj][3] * r * gn[3] * sigmoidf_(bfhi(og[jj].y));
                    u32x2 w; w.x = pk2(y0, y1); w.y = pk2(y2, y3);
                    *(u32x2*)(yr + 16 * j) = w; } }
        }
        BAR_LDS();
    }
}

__device__ __forceinline__ void mix_phase(Frame& F, int l) {
    unsigned char* ws = kws(); const bf16* Z = (const bf16*)(ws + WS_Z); bf16* YS = (bf16*)(ws + WS_YS);
    const float* cw = kin(I_CMW) + (size_t)l * 3 * MIXW;
    const int sub = F.tid >> 7, tcol = F.tid & 127, c = 8 * tcol, win = 2 << (tcol >> 5);
    float w0[8], w1[8], w2[8];
#pragma unroll
    for (int j = 0; j < 8; ++j) { w0[j] = cw[c + j]; w1[j] = cw[MIXW + c + j]; w2[j] = cw[2 * MIXW + c + j]; }
    const u32x4 zero4 = {0u, 0u, 0u, 0u};
    for (int run = blockIdx.x * 4 + sub; run < MR / 16 + 1; run += F.G * 4) {
        int b, pos0; if (run < MR / 16) { b = run >> 8; pos0 = NMETA + (run & 255) * 16; } else { b = 0; pos0 = 0; }
        float S[8], z1[8], z2[8];
#pragma unroll
        for (int j = 0; j < 8; ++j) { S[j] = 0.f; z1[j] = 0.f; z2[j] = 0.f; }
        for (int k = 1; k <= 16; ++k) { if (k <= win && pos0 - k >= 0) { float f[8]; unpack8(*(const u32x4*)(Z + (size_t)prow(b, pos0 - k) * ZP + ZPU + c), f);
#pragma unroll
                for (int j = 0; j < 8; ++j) S[j] += f[j]; } }
        if (pos0 >= 1) { const bf16* zz = Z + (size_t)prow(b, pos0 - 1) * ZP; float a[8], x[8]; unpack8(*(const u32x4*)(zz + ZCC + c), a); unpack8(*(const u32x4*)(zz + ZCX + c), x);
#pragma unroll
            for (int j = 0; j < 8; ++j) z1[j] = a[j] * x[j]; }
        if (pos0 >= 2) { const bf16* zz = Z + (size_t)prow(b, pos0 - 2) * ZP; float a[8], x[8]; unpack8(*(const u32x4*)(zz + ZCC + c), a); unpack8(*(const u32x4*)(zz + ZCX + c), x);
#pragma unroll
            for (int j = 0; j < 8; ++j) z2[j] = a[j] * x[j]; }
        for (int t0 = 0; t0 < 16; t0 += 4) {
            u32x4 cbw[4], ccw[4], cxw[4], puw[4], olw[4];
#pragma unroll
            for (int i = 0; i < 4; ++i) { const int pos = pos0 + t0 + i; const bf16* zr = Z + (size_t)prow(b, pos) * ZP;
                cbw[i] = *(const u32x4*)(zr + ZCB + c); ccw[i] = *(const u32x4*)(zr + ZCC + c); cxw[i] = *(const u32x4*)(zr + ZCX + c); puw[i] = *(const u32x4*)(zr + ZPU + c);
                olw[i] = pos - win >= 0 ? *(const u32x4*)(Z + (size_t)prow(b, pos - win) * ZP + ZPU + c) : zero4; }
#pragma unroll
            for (int i = 0; i < 4; ++i) { const int pos = pos0 + t0 + i; const int row = prow(b, pos);
                float cb[8], cc[8], cx[8], pu[8], ol[8], yb[8], yc[8];
                unpack8(cbw[i], cb); unpack8(ccw[i], cc); unpack8(cxw[i], cx); unpack8(puw[i], pu); unpack8(olw[i], ol);
                const int cnt = pos + 1 < win ? pos + 1 : win; const float inv = 1.0f / (float)cnt;
#pragma unroll
                for (int j = 0; j < 8; ++j) { const float zc = cc[j] * cx[j];
                    yb[j] = cb[j] * (w0[j] * z2[j] + w1[j] * z1[j] + w2[j] * zc); z2[j] = z1[j]; z1[j] = zc;
                    S[j] += pu[j] - ol[j]; yc[j] = S[j] * inv - pu[j]; }
                bf16* yr = YS + (size_t)row * 3072;
                *(u32x4*)(yr + MIXW + c) = pack8(yb); *(u32x4*)(yr + 2 * MIXW + c) = pack8(yc);
            }
        }
    }
}

__device__ __forceinline__ void act_fix_phase(Frame& F, int l) {
    unsigned char* ws = kws(); const float* EA = (const float*)(ws + WS_EA); const float* EU = (const float*)(ws + WS_EU); const float* AUM = (const float*)(ws + WS_AUM); bf16* ACT = (bf16*)(ws + WS_ACT);
    const float* cw = kin(I_FCW) + (size_t)l * 3 * DFF;
    constexpr int NROWS = 64 * 2 + NMETA;
    for (int e = blockIdx.x * NTHREADS + F.tid; e < NROWS * DFF; e += F.G * NTHREADS) {
        const int ri = e / DFF, c = e - ri * DFF; const int cm = (c >> 7) * 256 + (c & 127);
        float a0 = 0.f, a1 = 0.f, a2, uu; int row;
        if (ri < 128) { const int pm = ri >> 1, j = ri & 1; row = pm * 256 + j;
            a2 = EA[((size_t)pm * 4 + 2 + j) * DFF + c]; uu = EU[((size_t)pm * 2 + j) * DFF + c];
            float p255, p254;
            if ((pm & 15) == 0) { p255 = AUM[(size_t)15 * 2 * DFF + cm]; p254 = AUM[(size_t)14 * 2 * DFF + cm]; }
            else { p255 = EA[((size_t)(pm - 1) * 4 + 1) * DFF + c]; p254 = EA[((size_t)(pm - 1) * 4 + 0) * DFF + c]; }
            if (j == 0) { a1 = p255; a0 = p254; } else { a1 = EA[((size_t)pm * 4 + 2) * DFF + c]; a0 = p255; }
        } else { const int p = ri - 128; row = MR + p;
            a2 = AUM[(size_t)p * 2 * DFF + cm]; uu = AUM[(size_t)p * 2 * DFF + cm + 128];
            if (p >= 1) a1 = AUM[(size_t)(p - 1) * 2 * DFF + cm]; if (p >= 2) a0 = AUM[(size_t)(p - 2) * 2 * DFF + cm]; }
        const float cv = cw[c] * a0 + cw[DFF + c] * a1 + cw[2 * DFF + c] * a2;
        ACT[(size_t)row * DFF + c] = (bf16)f2bf(gelu_tanh(cv) * uu);
    }
}

#define WSP(T, off) ((T*)(ws + (off)))
__global__ void __launch_bounds__(NTHREADS, 2) fwd(Args args_unused) {
    extern __shared__ __attribute__((aligned(16))) unsigned char lds_raw[];
    Frame F;
    F.lds = (LAS unsigned char*)lds_raw;
    F.tid = threadIdx.x; F.lane = F.tid & 63; F.wave = __builtin_amdgcn_readfirstlane(F.tid >> 6);
    F.G = gridDim.x; F.gw = blockIdx.x * NWAVES + F.wave; F.ngw = F.G * NWAVES;
    volatile LAS unsigned* MISC = (volatile LAS unsigned*)(F.lds + MISC_OFF);
    for (int u = F.tid; u < (LDS_BYTES - LDSCTL_OFF) / 4; u += NTHREADS) ((LAS unsigned*)(F.lds + LDSCTL_OFF))[u] = 0u;
    __syncthreads();
    int lo, hi; { kptr_t kb = kbase(); lo = *(const int __attribute__((address_space(4)))*)(kb + 152); hi = *(const int __attribute__((address_space(4)))*)(kb + 156); }
    const bool multi = (hi - lo) > 1;
    if (multi) (void)xcd_barrier_post((unsigned*)(kws() + WS_CTL) + CW_BAR, MISC + 8);
#ifndef PH_MASK
#define PH_MASK 0x1fff
#endif
#define IN(k) (lo <= (k) && (k) < hi)
#define PM(k) ((PH_MASK >> (k)) & 1)
#ifndef REP_MASK
#define REP_MASK 0
#endif
#define NREP(k) (((REP_MASK >> (k)) & 1) ? 2 : 1)
#define SEAM(k) do { if (IN(k) && IN((k) + 1)) { XcdBarrier bar_; bar_.bar = (unsigned*)(kws() + WS_CTL) + CW_BAR; bar_.x = xb_xcc_id(); bar_.st = (volatile LAS unsigned*)(F.lds + MISC_OFF) + 8; xcd_barrier(bar_, F.wave == 0 && lane_id() == 0); } } while (0)

    if (PM(0) && IN(0)) { for (int rep = 0; rep < NREP(0); ++rep) weights_phase(F, 0); norm0_phase(F); SEAM(0); }

    for (int l = 0; l < DEPTH; ++l) {
        const int pb = 1 + NPL * l;
#define REFRESH() refresh(F)
        if (PM(1) && IN(pb + 0)) { REFRESH();
            unsigned char* ws = kws();
            const bf16* H = WSP(const bf16, WS_H); const bf16* Bt_in = WSP(const bf16, WS_W + W_IN); bf16* Z = WSP(bf16, WS_Z); float* IFb = WSP(float, WS_IF);
            const unsigned char* H8 = WSP(const unsigned char, WS_H8); const unsigned char* Bt_g8 = (const unsigned char*)(Bt_in + (size_t)ZG * DM);
            {
                pg8::Gemm g{H, Bt_in, DM, DM, DM}; pg8::OrderStd S; S.init(MR, ZG, F.G, (int)blockIdx.x);
                pg8::EpiBf16 E{Z, ZP, 1 << 30, 1.0f};
                for (int rep = 0; rep < NREP(1); ++rep)
                pg8::gemm_phase<pg8::EpiBf16, pg8::OrderStd, true>(F.lds, g, S, E, F.wave);
            }
            {
                pg8::Gemm g{(const bf16*)H8, (const bf16*)Bt_g8, DM / 2, DM / 2, DM / 2}; pg8::OrderStd S; S.init(MR, 3 * DM, F.G, (int)blockIdx.x);
                pg8::EpiGate E{WSP(unsigned char, WS_GT), 1.0f / W8_SCALE};
                for (int rep = 0; rep < NREP(5); ++rep)
                pg8::gemm_phase<pg8::EpiGate, pg8::OrderStd, true, true>(F.lds, g, S, E, F.wave);
            }
            LAS f32x4* red = (LAS f32x4*)F.lds;
            constexpr int T_IF = MT / 16, T_MB = ZG / 16, T_MG = 3 * DM / 16;
            thin_wg<4, 2>(F, T_IF + T_MB + T_MG, red,
                [&](int ti, int ks) { if (ti < T_IF) return thin_part(H + (size_t)ti * 16 * DM, DM, Bt_in + (size_t)NIN * DM, DM, ks * (DM / 2), DM / 2, F.lane);
                    ti -= T_IF; if (ti < T_MB) return thin_part(H + (size_t)MR * DM, DM, Bt_in + (size_t)ti * 16 * DM, DM, ks * (DM / 2), DM / 2, F.lane);
                    ti -= T_MB; return thin_part8(H8 + (size_t)MR * DM, DM, Bt_g8 + (size_t)ti * 16 * DM, DM, ks * (DM / 2), DM / 2, F.lane); },
                [&](int ti, f32x4 a) {
                    if (ti < T_IF) {
#pragma unroll
                        for (int i = 0; i < 4; ++i) IFb[(size_t)(ti * 16 + 4 * (F.lane >> 4) + i) * 16 + (F.lane & 15)] = a[i];
                        return; }
                    ti -= T_IF;
                    if (ti < T_MB) { const int col = ti * 16 + (F.lane & 15);
#pragma unroll
                        for (int i = 0; i < 4; ++i) { const int row = MR + 4 * (F.lane >> 4) + i; Z[(size_t)row * ZP + col] = (bf16)f2bf(a[i]); }
                        return; }
                    ti -= T_MB; { const int col = ti * 16 + (F.lane & 15); bf16* GM = WSP(bf16, WS_GM);
#pragma unroll
                        for (int i = 0; i < 4; ++i) GM[(4 * (F.lane >> 4) + i) * (3 * DM) + col] = (bf16)f2bf(sigmoidf_(a[i] * (1.0f / W8_SCALE))); } });
            SEAM(pb + 0);
        }
        if (PM(2) && IN(pb + 1)) { REFRESH(); for (int rep = 0; rep < NREP(2); ++rep) mlstm_u_phase(F, l); for (int rep = 0; rep < NREP(5); ++rep) mix_phase(F, l); SEAM(pb + 1); }
        if (PM(3) && IN(pb + 2)) { REFRESH(); mlstm_scan_phase(F); SEAM(pb + 2); }
        if (PM(4) && IN(pb + 3)) { REFRESH(); for (int rep = 0; rep < NREP(4); ++rep) mlstm_out_phase(F, l); SEAM(pb + 3); }
        if (PM(6) && IN(pb + 5)) { REFRESH();
            unsigned char* ws = kws();
            const bf16* YS = WSP(const bf16, WS_YS); const bf16* Bt_br = WSP(const bf16, WS_W + W_BR); const bf16* GM = WSP(const bf16, WS_GM); bf16* MG = WSP(bf16, WS_MG);
            pg8::Gemm g{YS, Bt_br, 3072, 3072, 3072}; pg8::OrderStd S; S.init(MR, DM, F.G, (int)blockIdx.x);
            pg8::EpiBranch E{WSP(const unsigned char, WS_GT), MG};
            for (int rep = 0; rep < NREP(6); ++rep)
            pg8::gemm_phase<pg8::EpiBranch, pg8::OrderStd, true>(F.lds, g, S, E, F.wave);
            thin_wg<1, 8>(F, DM / 16, (LAS f32x4*)F.lds,
                [&](int ti, int ks) { const int col = ti * 16 + (F.lane & 15); f32x4 tot = {0.f, 0.f, 0.f, 0.f};
#pragma unroll
                    for (int n = 0; n < 3; ++n) { const f32x4 a = thin_part(YS + (size_t)MR * 3072 + n * MIXW, 3072, Bt_br + (size_t)ti * 16 * 3072 + n * MIXW, 3072, ks * (MIXW / 8), MIXW / 8, F.lane);
#pragma unroll
                        for (int i = 0; i < 4; ++i) tot[i] += a[i] * bf2f(GM[(4 * (F.lane >> 4) + i) * (3 * DM) + n * DM + col]); }
                    return tot; },
                [&](int ti, f32x4 a) { const int col = ti * 16 + (F.lane & 15);
#pragma unroll
                    for (int i = 0; i < 4; ++i) MG[(size_t)(MR + 4 * (F.lane >> 4) + i) * DM + col] = (bf16)f2bf(a[i]); });
            SEAM(pb + 5);
        }
        if (PM(7) && IN(pb + 6)) { REFRESH();
            unsigned char* ws = kws();
            const bf16* MG = WSP(const bf16, WS_MG); const bf16* Bt_out = WSP(const bf16, WS_W + W_OUT); bf16* MIX = WSP(bf16, WS_MIX);
            pg8::Gemm g{MG, Bt_out, DM, DM, DM}; pg8::OrderStd S; S.init(MR, DM, F.G, (int)blockIdx.x);
            pg8::EpiBf16 E{MIX, DM, 1 << 30, 1.0f};
            for (int rep = 0; rep < NREP(7); ++rep)
            pg8::gemm_phase<pg8::EpiBf16, pg8::OrderStd, true>(F.lds, g, S, E, F.wave);
            thin_wg<1, 8>(F, DM / 16, (LAS f32x4*)F.lds,
                [&](int ti, int ks) { return thin_part(MG + (size_t)MR * DM, DM, Bt_out + (size_t)ti * 16 * DM, DM, ks * (DM / 8), DM / 8, F.lane); },
                [&](int ti, f32x4 a) {
#pragma unroll
                    for (int i = 0; i < 4; ++i) MIX[(size_t)(MR + 4 * (F.lane >> 4) + i) * DM + ti * 16 + (F.lane & 15)] = (bf16)f2bf(a[i]); });
            SEAM(pb + 6);
        }
        if (PM(8) && IN(pb + 7)) { REFRESH();
            unsigned char* ws = kws();
            for (int rep = 0; rep < (l == 0 ? NREP(8) : 1); ++rep)
            nrn_phase(F, WSP(const bf16, WS_MIX), l == 0 ? (const void*)kin(I_X) : (const void*)kout(), l != 0, l == 0 ? kin(I_META) : WSP(const float, WS_XM), WSP(void, WS_XB), true, kin(I_NQM) + (size_t)l * DM, kin(I_NPF) + (size_t)l * DM, false);
            SEAM(pb + 7);
        }
        if (PM(9) && IN(pb + 8)) { REFRESH();
            unsigned char* ws = kws();
            const bf16* H = WSP(const bf16, WS_H); const bf16* Bt_ffi = WSP(const bf16, WS_W + W_FFI); float* AUM = WSP(float, WS_AUM);
            pg8::Gemm g{H, Bt_ffi, DM, DM, DM}; pg8::OrderStd S; S.init(MR, 2 * DFF, F.G, (int)blockIdx.x);
            pg8::EpiAct E{WSP(bf16, WS_ACT), WSP(float, WS_EA), WSP(float, WS_EU), kin(I_FCW) + (size_t)l * 3 * DFF, (LAS float*)(F.lds + XCH_OFF)};
            for (int rep = 0; rep < NREP(9); ++rep)
            pg8::gemm_phase<pg8::EpiAct, pg8::OrderStd, true>(F.lds, g, S, E, F.wave);
            thin_wg<4, 2>(F, 2 * DFF / 16, (LAS f32x4*)F.lds,
                [&](int ti, int ks) { return thin_part(H + (size_t)MR * DM, DM, Bt_ffi + (size_t)ti * 16 * DM, DM, ks * (DM / 2), DM / 2, F.lane); },
                [&](int ti, f32x4 a) {
#pragma unroll
                    for (int i = 0; i < 4; ++i) AUM[(size_t)(4 * (F.lane >> 4) + i) * (2 * DFF) + ti * 16 + (F.lane & 15)] = a[i]; });
            SEAM(pb + 8);
        }
        if (PM(10) && IN(pb + 9)) { REFRESH(); act_fix_phase(F, l); SEAM(pb + 9); }
        if (PM(11) && IN(pb + 10)) { REFRESH();
            unsigned char* ws = kws();
            const bf16* ACT = WSP(const bf16, WS_ACT); const bf16* Bt_ffo = WSP(const bf16, WS_W + W_FFO); bf16* MIX = WSP(bf16, WS_MIX);
            pg8::Gemm g{ACT, Bt_ffo, DFF, DFF, DFF}; pg8::OrderStd S; S.init(MR, DM, F.G, (int)blockIdx.x);
            pg8::EpiBf16 E{MIX, DM, 1 << 30, 1.0f};
            for (int rep = 0; rep < NREP(11); ++rep)
            pg8::gemm_phase<pg8::EpiBf16, pg8::OrderStd, true>(F.lds, g, S, E, F.wave);
            thin_wg<1, 8>(F, DM / 16, (LAS f32x4*)F.lds,
                [&](int ti, int ks) { return thin_part(ACT + (size_t)MR * DFF, DFF, Bt_ffo + (size_t)ti * 16 * DFF, DFF, ks * (DFF / 8), DFF / 8, F.lane); },
                [&](int ti, f32x4 a) {
#pragma unroll
                    for (int i = 0; i < 4; ++i) MIX[(size_t)(MR + 4 * (F.lane >> 4) + i) * DM + ti * 16 + (F.lane & 15)] = (bf16)f2bf(a[i]); });
            SEAM(pb + 10);
        }
        if (PM(12) && IN(pb + 11)) { REFRESH();
            unsigned char* ws = kws();
            nrn_phase(F, WSP(const bf16, WS_MIX), WSP(const void, WS_XB), true, WSP(const float, WS_XM), (void*)kout(), l + 1 < DEPTH, kin(I_NQF) + (size_t)l * DM, l + 1 < DEPTH ? kin(I_NPM) + (size_t)(l + 1) * DM : nullptr, true);
            if (l + 1 < DEPTH) weights_phase(F, l + 1);
            SEAM(pb + 11);
        }
    }
#undef IN
#undef SEAM
}

#ifndef N_LAUNCH_SPLIT
#define N_LAUNCH_SPLIT 0
#endif
extern "C" void kernel_launch(void* const* d_in, const int* in_sizes, int n_in, void* d_out, int out_size, void* d_ws, size_t ws_size, hipStream_t stream) {
    static int grid = 0;
    if (grid == 0) {
        if (n_in != 17 || out_size != MR * DM || ws_size < WS_END) { fprintf(stderr, "kernel_launch: unexpected sizes n_in %d out %d ws %zu (need %zu)\n", n_in, out_size, ws_size, (size_t)WS_END); grid = -1; return; }
        int dev = 0, cus = 0, per_cu = 0;
        if (hipGetDevice(&dev) != hipSuccess || hipDeviceGetAttribute(&cus, hipDeviceAttributeMultiprocessorCount, dev) != hipSuccess) { grid = -1; return; }
        if (hipFuncSetAttribute((const void*)fwd, hipFuncAttributeMaxDynamicSharedMemorySize, LDS_BYTES) != hipSuccess) { fprintf(stderr, "kernel_launch: hipFuncSetAttribute failed\n"); grid = -1; return; }
        if (hipOccupancyMaxActiveBlocksPerMultiprocessor(&per_cu, (const void*)fwd, NTHREADS, LDS_BYTES) != hipSuccess || per_cu < 1) { fprintf(stderr, "kernel_launch: occupancy query says %d\n", per_cu); }
        (void)hipGetLastError();
        grid = cus;
    }
    if (grid < 0) return;
    (void)hipMemsetAsync((char*)d_ws + WS_CTL, 0, CTL_ZERO_BYTES, stream);
    Args a{};
    for (int i = 0; i < 17; ++i) a.in[i] = (const float*)d_in[i];
    a.out = (float*)d_out; a.ws = (unsigned char*)d_ws;
#if N_LAUNCH_SPLIT
    for (int p = 0; p < N_PHASES; ++p) { a.ph_lo = p; a.ph_hi = p + 1; hipLaunchKernelGGL(fwd, dim3(grid), dim3(NTHREADS), LDS_BYTES, stream, a); }
#else
    a.ph_lo = 0; a.ph_hi = N_PHASES; hipLaunchKernelGGL(fwd, dim3(grid), dim3(NTHREADS), LDS_BYTES, stream, a);
#endif
}
```
